# Optimizing an MI355X kernel written in HIP

```python
import jax, jax.numpy as jnp
from jax import lax
import numpy as np

D_MODEL = 1024
BATCH = 32
SEQ = 2048
DEPTH = 1

D_LRU = D_MODEL
LRU_BLOCKS = 16
LRU_BLOCK_DIM = D_LRU // LRU_BLOCKS
CONV_WIDTH = 4
LRU_C = 8.0
GLA_HEADS = 4
GLA_QK_DIM = D_MODEL // 2
GLA_V_DIM = D_MODEL
GLA_DK = GLA_QK_DIM // GLA_HEADS
GLA_DV = GLA_V_DIM // GLA_HEADS
GLA_GATE_RANK = 16
GLA_TAU = 16.0
GLA_CHUNK = 64
N_EXPERTS = 256
TOP_K = 8
N_GROUPS = 8
TOPK_GROUPS = 4
D_EXPERT = 256
D_SHARED = 256
ROUTED_SCALE = 2.5
MOE_BLOCK = 128
DN_ALPHA = (2.0 * DEPTH) ** 0.25
DN_BETA = (8.0 * DEPTH) ** -0.25
LN_EPS = 1e-5
RMS_EPS = 1e-6

SPLIT_SIZES = (D_LRU, D_LRU, GLA_QK_DIM, GLA_QK_DIM, GLA_V_DIM, GLA_V_DIM, GLA_GATE_RANK, D_MODEL, D_MODEL)
D_PROJ = sum(SPLIT_SIZES)
SPLIT_POINTS = tuple(sum(SPLIT_SIZES[:i + 1]) for i in range(len(SPLIT_SIZES) - 1))

kernel_name = 'hybrid_rglru_gla_moe_deepnorm'


def layer_norm(x, g, b):
    xf = x.astype(jnp.float32)
    mu = jnp.mean(xf, axis=-1, keepdims=True)
    var = jnp.mean(jnp.square(xf - mu), axis=-1, keepdims=True)
    y = (xf - mu) * lax.rsqrt(var + LN_EPS) * g.astype(jnp.float32) + b.astype(jnp.float32)
    return y.astype(x.dtype)


def linear_scan(a, u):
    def step(h_prev, au):
        a_t, u_t = au
        h_t = a_t * h_prev + u_t
        return h_t, h_t
    h0 = jnp.zeros((a.shape[0], a.shape[2]), a.dtype)
    _, hs = lax.scan(step, h0, (jnp.moveaxis(a, 1, 0), jnp.moveaxis(u, 1, 0)))
    return jnp.moveaxis(hs, 0, 1)


def rglru_branch(xa, ga, conv_w, conv_b, lru_w_a, lru_b_a, lru_w_x, lru_b_x, lru_lambda):
    b_, s_, _ = xa.shape
    xc = lax.conv_general_dilated(xa, conv_w[:, None, :], window_strides=(1,),
                                  padding=((CONV_WIDTH - 1, 0),),
                                  dimension_numbers=('NWC', 'WIO', 'NWC'),
                                  feature_group_count=D_LRU) + conv_b
    xb = xc.reshape(b_, s_, LRU_BLOCKS, LRU_BLOCK_DIM)
    r = jax.nn.sigmoid(jnp.einsum('bsgi,gij->bsgj', xb, lru_w_a).reshape(b_, s_, D_LRU) + lru_b_a)
    i = jax.nn.sigmoid(jnp.einsum('bsgi,gij->bsgj', xb, lru_w_x).reshape(b_, s_, D_LRU) + lru_b_x)
    log_a = (-LRU_C * r * jax.nn.softplus(-lru_lambda)).astype(jnp.float32)
    a = jnp.exp(log_a)
    u = jnp.sqrt(-jnp.expm1(2.0 * log_a)) * (i * xc).astype(jnp.float32)
    h = linear_scan(a, u)
    return h.astype(xa.dtype) * jax.nn.gelu(ga)


def gla_chunked(q, k, v, log_a):
    b_, s_, h_, dk = q.shape
    dv = v.shape[-1]
    n_ch = s_ // GLA_CHUNK
    def to_chunks(t):
        return t.reshape(b_, n_ch, GLA_CHUNK, h_, t.shape[-1])
    q, k, v, log_a = to_chunks(q), to_chunks(k), to_chunks(v), to_chunks(log_a)
    bcum = jnp.cumsum(log_a, axis=2)
    b_last = bcum[:, :, -1:]
    q_dec = q * jnp.exp(bcum)
    k_inv = k * jnp.exp(-bcum)
    k_end = k * jnp.exp(b_last - bcum)
    causal = jnp.tril(jnp.ones((GLA_CHUNK, GLA_CHUNK), dtype=bool))
    scores = jnp.einsum('bnihk,bnjhk->bnhij', q_dec, k_inv)
    scores = jnp.where(causal, scores, 0.0)
    o_intra = jnp.einsum('bnhij,bnjhv->bnihv', scores, v)

    def step(state, inp):
        q_n, k_n, v_n, g_n = inp
        o_n = jnp.einsum('bchk,bhkv->bchv', q_n, state)
        state = g_n[..., None] * state + jnp.einsum('bchk,bchv->bhkv', k_n, v_n)
        return state, o_n
    xs = (jnp.moveaxis(q_dec, 1, 0), jnp.moveaxis(k_end, 1, 0), jnp.moveaxis(v, 1, 0),
          jnp.moveaxis(jnp.exp(b_last[:, :, 0]), 1, 0))
    state0 = jnp.zeros((b_, h_, dk, dv), jnp.float32)
    _, o_inter = lax.scan(step, state0, xs)
    o = o_intra + jnp.moveaxis(o_inter, 0, 1)
    return o.reshape(b_, s_, h_, dv)


def gla_branch(q, k, v, r, g_low, gla_w_gate_up, gla_b_gate, gla_norm_g):
    b_, s_, _ = q.shape
    f32 = jnp.float32
    qh = q.reshape(b_, s_, GLA_HEADS, GLA_DK).astype(f32) * (GLA_DK ** -0.5)
    kh = k.reshape(b_, s_, GLA_HEADS, GLA_DK).astype(f32)
    vh = v.reshape(b_, s_, GLA_HEADS, GLA_DV).astype(f32)
    gate_logit = (jnp.einsum('bsr,rk->bsk', g_low, gla_w_gate_up) + gla_b_gate).astype(f32)
    log_a = (jax.nn.log_sigmoid(gate_logit) / GLA_TAU).reshape(b_, s_, GLA_HEADS, GLA_DK)
    o = gla_chunked(qh, kh, vh, log_a)
    o = o * lax.rsqrt(jnp.mean(jnp.square(o), axis=-1, keepdims=True) + RMS_EPS)
    o = o * gla_norm_g.astype(f32).reshape(GLA_HEADS, GLA_DV)
    return o.reshape(b_, s_, GLA_V_DIM).astype(q.dtype) * jax.nn.silu(r)


def token_mixer(x, w_in, conv_w, conv_b, lru_w_a, lru_b_a, lru_w_x, lru_b_x, lru_lambda, w_lru_out,
                gla_w_gate_up, gla_b_gate, gla_norm_g, w_gla_out, w_mix_out):
    p = jnp.einsum('bsd,de->bse', x, w_in)
    xa, ga, q, k, v, r, g_low, gate_a, gate_b = jnp.split(p, SPLIT_POINTS, axis=-1)
    y_a = jnp.einsum('bsc,cd->bsd',
                     rglru_branch(xa, ga, conv_w, conv_b, lru_w_a, lru_b_a, lru_w_x, lru_b_x, lru_lambda),
                     w_lru_out)
    y_b = jnp.einsum('bsc,cd->bsd',
                     gla_branch(q, k, v, r, g_low, gla_w_gate_up, gla_b_gate, gla_norm_g),
                     w_gla_out)
    merged = jax.nn.sigmoid(gate_a) * y_a + jax.nn.sigmoid(gate_b) * y_b
    return jnp.einsum('bsd,de->bse', merged, w_mix_out)


def swiglu(xt, w_gate, w_up, w_down):
    return (jax.nn.silu(xt @ w_gate) * (xt @ w_up)) @ w_down


def moe(h, w_router, router_bias, w_exp_gate, w_exp_up, w_exp_down, w_sh_gate, w_sh_up, w_sh_down):
    b_, s_, d_ = h.shape
    n_tok = b_ * s_
    hf = h.reshape(n_tok, d_)
    scores = jax.nn.sigmoid((hf @ w_router).astype(jnp.float32))
    biased = scores + router_bias.astype(jnp.float32)
    grp_score = lax.top_k(biased.reshape(n_tok, N_GROUPS, N_EXPERTS // N_GROUPS), 2)[0].sum(-1)
    _, top_g = lax.top_k(grp_score, TOPK_GROUPS)
    gmask = jnp.any(top_g[..., None] == jnp.arange(N_GROUPS), axis=1)
    emask = jnp.repeat(gmask, N_EXPERTS // N_GROUPS, axis=1)
    _, idx = lax.top_k(jnp.where(emask, biased, -jnp.inf), TOP_K)
    w = jnp.take_along_axis(scores, idx, axis=1)
    w = w / jnp.sum(w, axis=-1, keepdims=True) * ROUTED_SCALE

    n_asg = n_tok * TOP_K
    n_blocks = (n_asg + MOE_BLOCK - 1) // MOE_BLOCK + N_EXPERTS
    e_flat = idx.reshape(-1)
    tok_flat = jnp.repeat(jnp.arange(n_tok, dtype=jnp.int32), TOP_K)
    w_flat = w.reshape(-1)
    order = jnp.argsort(e_flat)
    e_s, tok_s, w_s = e_flat[order], tok_flat[order], w_flat[order]
    counts = jax.ops.segment_sum(jnp.ones_like(e_flat), e_flat, num_segments=N_EXPERTS)
    padded = (counts + MOE_BLOCK - 1) // MOE_BLOCK * MOE_BLOCK
    start = jnp.cumsum(counts) - counts
    pend = jnp.cumsum(padded)
    pstart = pend - padded
    dest = pstart[e_s] + (jnp.arange(n_asg, dtype=jnp.int32) - start[e_s])
    slot_tok = jnp.full((n_blocks * MOE_BLOCK,), n_tok, jnp.int32).at[dest].set(tok_s)
    slot_w = jnp.zeros((n_blocks * MOE_BLOCK,), jnp.float32).at[dest].set(w_s)
    block_expert = jnp.minimum(
        jnp.searchsorted(pend, jnp.arange(n_blocks, dtype=jnp.int32) * MOE_BLOCK, side='right'),
        N_EXPERTS - 1)
    h_pad = jnp.concatenate([hf, jnp.zeros((1, d_), hf.dtype)], axis=0)

    def body(acc, blk):
        toks, wts, e = blk
        xb = h_pad[toks]
        y = swiglu(xb, w_exp_gate[e], w_exp_up[e], w_exp_down[e])
        return acc.at[toks].add(y * wts[:, None].astype(y.dtype)), None
    acc0 = jnp.zeros((n_tok + 1, d_), hf.dtype)
    acc, _ = lax.scan(body, acc0, (slot_tok.reshape(n_blocks, MOE_BLOCK),
                                   slot_w.reshape(n_blocks, MOE_BLOCK), block_expert))
    out = acc[:n_tok] + swiglu(hf, w_sh_gate, w_sh_up, w_sh_down)
    return out.reshape(b_, s_, d_)


def hybrid_layer(x, w_in, conv_w, conv_b, lru_w_a, lru_b_a, lru_w_x, lru_b_x, lru_lambda, w_lru_out,
                 gla_w_gate_up, gla_b_gate, gla_norm_g, w_gla_out, w_mix_out, ln1_g, ln1_b,
                 w_router, router_bias, w_exp_gate, w_exp_up, w_exp_down, w_sh_gate, w_sh_up, w_sh_down,
                 ln2_g, ln2_b):
    mix = token_mixer(x, w_in, conv_w, conv_b, lru_w_a, lru_b_a, lru_w_x, lru_b_x, lru_lambda, w_lru_out,
                      gla_w_gate_up, gla_b_gate, gla_norm_g, w_gla_out, w_mix_out)
    h = layer_norm(DN_ALPHA * x + mix, ln1_g, ln1_b)
    ffn = moe(h, w_router, router_bias, w_exp_gate, w_exp_up, w_exp_down, w_sh_gate, w_sh_up, w_sh_down)
    return layer_norm(DN_ALPHA * h + ffn, ln2_g, ln2_b)


def setup_inputs(seed: int = 0) -> dict:
    key = jax.random.key(seed)
    ks = jax.random.split(key, 32)
    L = DEPTH
    f32 = jnp.float32

    def nrm(k, shape, fan_in, scale=1.0):
        return jax.random.normal(k, shape, f32) * (scale * fan_in ** -0.5)

    def gain(k, n):
        return 1.0 + 0.05 * jax.random.normal(k, (L, n), f32)

    def bias(k, n, s=0.02):
        return s * jax.random.normal(k, (L, n), f32)

    u = jax.random.uniform(ks[8], (L, D_LRU), f32, minval=0.9, maxval=0.999)
    a0 = u ** (1.0 / LRU_C)
    lru_lambda = jnp.log(a0) - jnp.log1p(-a0)
    return {
        'x': jax.random.normal(ks[0], (BATCH, SEQ, D_MODEL), f32),
        'w_in': nrm(ks[1], (L, D_MODEL, D_PROJ), D_MODEL),
        'conv_w': nrm(ks[2], (L, CONV_WIDTH, D_LRU), CONV_WIDTH),
        'conv_b': bias(ks[3], D_LRU),
        'lru_w_a': nrm(ks[4], (L, LRU_BLOCKS, LRU_BLOCK_DIM, LRU_BLOCK_DIM), LRU_BLOCK_DIM),
        'lru_b_a': bias(ks[5], D_LRU),
        'lru_w_x': nrm(ks[6], (L, LRU_BLOCKS, LRU_BLOCK_DIM, LRU_BLOCK_DIM), LRU_BLOCK_DIM),
        'lru_b_x': bias(ks[7], D_LRU),
        'lru_lambda': lru_lambda,
        'w_lru_out': nrm(ks[9], (L, D_LRU, D_MODEL), D_LRU, DN_BETA),
        'gla_w_gate_up': nrm(ks[10], (L, GLA_GATE_RANK, GLA_QK_DIM), GLA_GATE_RANK),
        'gla_b_gate': bias(ks[11], GLA_QK_DIM, 0.1),
        'gla_norm_g': gain(ks[12], GLA_V_DIM),
        'w_gla_out': nrm(ks[13], (L, GLA_V_DIM, D_MODEL), GLA_V_DIM, DN_BETA),
        'w_mix_out': nrm(ks[14], (L, D_MODEL, D_MODEL), D_MODEL, DN_BETA),
        'ln1_g': gain(ks[15], D_MODEL),
        'ln1_b': bias(ks[16], D_MODEL),
        'w_router': nrm(ks[17], (L, D_MODEL, N_EXPERTS), D_MODEL),
        'router_bias': bias(ks[18], N_EXPERTS, 0.01),
        'w_exp_gate': nrm(ks[19], (L, N_EXPERTS, D_MODEL, D_EXPERT), D_MODEL),
        'w_exp_up': nrm(ks[20], (L, N_EXPERTS, D_MODEL, D_EXPERT), D_MODEL),
        'w_exp_down': nrm(ks[21], (L, N_EXPERTS, D_EXPERT, D_MODEL), D_EXPERT, DN_BETA),
        'w_sh_gate': nrm(ks[22], (L, D_MODEL, D_SHARED), D_MODEL),
        'w_sh_up': nrm(ks[23], (L, D_MODEL, D_SHARED), D_MODEL),
        'w_sh_down': nrm(ks[24], (L, D_SHARED, D_MODEL), D_SHARED, DN_BETA),
        'ln2_g': gain(ks[25], D_MODEL),
        'ln2_b': bias(ks[26], D_MODEL),
    }


def reference(x, w_in, conv_w, conv_b, lru_w_a, lru_b_a, lru_w_x, lru_b_x, lru_lambda, w_lru_out,
              gla_w_gate_up, gla_b_gate, gla_norm_g, w_gla_out, w_mix_out, ln1_g, ln1_b,
              w_router, router_bias, w_exp_gate, w_exp_up, w_exp_down, w_sh_gate, w_sh_up, w_sh_down,
              ln2_g, ln2_b):
    layer_params = (w_in, conv_w, conv_b, lru_w_a, lru_b_a, lru_w_x, lru_b_x, lru_lambda, w_lru_out,
                    gla_w_gate_up, gla_b_gate, gla_norm_g, w_gla_out, w_mix_out, ln1_g, ln1_b,
                    w_router, router_bias, w_exp_gate, w_exp_up, w_exp_down, w_sh_gate, w_sh_up, w_sh_down,
                    ln2_g, ln2_b)
    h = x
    for l in range(DEPTH):
        h = hybrid_layer(h, *(p[l] for p in layer_params))
    return h
```

```cpp
#include <hip/hip_runtime.h>
#include <cstdio>
#include <cstdint>

#ifndef GEMM_FAST
#define GEMM_FAST 1
#endif
#ifndef PG_SP2
#define PG_SP2 true
#endif
#ifndef PG_ALIGN
#define PG_ALIGN true
#endif
#ifndef PROBE_PHASE
#define PROBE_PHASE -1
#endif
#ifndef INPROJ_FP8
#define INPROJ_FP8 1
#endif
#ifndef MK_N_LAUNCHES
#define MK_N_LAUNCHES 1
#endif

namespace {
#define LAS __attribute__((address_space(3)))
typedef unsigned short bf16;
typedef short bf16x8 __attribute__((ext_vector_type(8)));
typedef float f32x4 __attribute__((ext_vector_type(4)));
typedef unsigned u32x4 __attribute__((ext_vector_type(4)));
typedef unsigned u32x2 __attribute__((ext_vector_type(2)));
typedef int v4i __attribute__((ext_vector_type(4)));
typedef int v8i __attribute__((ext_vector_type(8)));

constexpr int T = 65536, D = 1024, SEQ = 2048;
constexpr int NPT = 28;
constexpr int C_XA = 0, C_GA = 1024, C_Q = 2048, C_K = 2560, C_V = 3072, C_R = 4096, C_GTA = 5120, C_GTB = 6144;
constexpr int NIN = 7424;
constexpr int DIN = 7184;
constexpr int NE = 256, TOPK = 8, DE = 256;
constexpr int SMAX = T * TOPK + NE * 256;
constexpr float DN_ALPHA = 1.189207115002721f;
constexpr float LN_EPS = 1e-5f, RMS_EPS = 1e-6f;

constexpr size_t MiB = 1u << 20;
constexpr size_t WS_CTL = 0, CTL_BYTES = 1 * MiB;
constexpr size_t WS_WIN = 1 * MiB;
constexpr size_t WS_WA = 16 * MiB, WS_WB = 18 * MiB, WS_WO = 20 * MiB;
constexpr size_t WS_WR = 22 * MiB;
constexpr size_t WS_WSGU = WS_WR + MiB / 2;
constexpr size_t WS_WSD = WS_WSGU + MiB;
constexpr size_t WS_LRUW = 24 * MiB;
constexpr size_t WS_GL = 25 * MiB;
constexpr size_t WS_H = 29 * MiB;
constexpr size_t WS_P = 157 * MiB;
constexpr size_t WS_END = WS_P + (size_t)896 * MiB;
constexpr size_t WS_WD8 = WS_P;
constexpr size_t WS_ACT8 = WS_P + 64 * MiB;
constexpr size_t WS_IDX = WS_P + 208 * MiB;
constexpr size_t WS_WT = WS_IDX + 2 * MiB;
constexpr size_t WS_RANK = WS_WT + 2 * MiB;
constexpr size_t WS_TSLOT = WS_RANK + 2 * MiB;
constexpr size_t WS_STOK = WS_TSLOT + 2 * MiB;
constexpr size_t WS_CNT = WS_STOK + 3 * MiB;
constexpr size_t WS_TILE = WS_CNT + 1 * MiB;
constexpr size_t WS_Y8 = WS_P + 320 * MiB;
constexpr size_t WS_WGU8 = WS_P + 320 * MiB;
constexpr int H8_PANEL = 256 * 2048;
constexpr size_t WS_H8 = WS_P + 224 * MiB;
constexpr size_t WS_LG = WS_P + 576 * MiB;
constexpr size_t WS_ACTSH = WS_P + 640 * MiB;
static_assert(WS_TILE + MiB <= WS_H8 && WS_H8 + 64 * MiB <= WS_Y8 && WS_Y8 + (size_t)SMAX * 1024 <= WS_END && WS_ACTSH + 32 * MiB <= WS_END, "MoE overlay map");
constexpr int FP8_Y_SHIFT = 5;
constexpr int FP8_W_SHIFT = 6, FP8_A_SHIFT = 3;

constexpr int CW_BAR = 4096, CW_MIXQ = 64;

constexpr int LDS_BYTES = 163840;
constexpr int MISC_OFF = LDS_BYTES - 256;

__device__ __forceinline__ size_t pt_off(size_t row, int col) { return (((row >> 8) * NPT + (size_t)(col >> 8)) << 16) + ((row & 255) << 8) + (size_t)(col & 255); }
__device__ __forceinline__ float bf2f(unsigned b) { return __uint_as_float(b << 16); }
typedef float f32x2_t __attribute__((ext_vector_type(2)));
typedef __bf16 bf16x2_t __attribute__((ext_vector_type(2)));
__device__ __forceinline__ unsigned cvt_pk_bf16(float lo, float hi) { const f32x2_t v = {lo, hi}; const bf16x2_t b = __builtin_convertvector(v, bf16x2_t); return __builtin_bit_cast(unsigned, b); }
__device__ __forceinline__ unsigned pk2(float lo, float hi) { return cvt_pk_bf16(lo, hi); }
__device__ __forceinline__ unsigned f2bf(float f) { return cvt_pk_bf16(f, f) & 0xffffu; }
__device__ __forceinline__ float lo16(unsigned w) { return __uint_as_float(w << 16); }
__device__ __forceinline__ float hi16(unsigned w) { return __uint_as_float(w & 0xffff0000u); }
__device__ __forceinline__ float sigmoidf_(float x) { return __builtin_amdgcn_rcpf(1.0f + __expf(-x)); }
__device__ __forceinline__ float siluf_(float x) { return x * sigmoidf_(x); }
__device__ __forceinline__ float gelu_tanh(float x) { return x * sigmoidf_(1.5957691216057308f * (x + 0.044715f * x * x * x)); }

__device__ __forceinline__ float lane_read(float v, int src_lane) { return __int_as_float(__builtin_amdgcn_ds_bpermute(src_lane << 2, __float_as_int(v))); }
template <int N> __device__ __forceinline__ float dpp_row_shr(float v, float oob) { return __int_as_float(__builtin_amdgcn_update_dpp(__float_as_int(oob), __float_as_int(v), 0x110 + N, 0xF, 0xF, false)); }
__device__ __forceinline__ float wave_incl_scan(float v) {
    v += dpp_row_shr<1>(v, 0.f); v += dpp_row_shr<2>(v, 0.f); v += dpp_row_shr<4>(v, 0.f); v += dpp_row_shr<8>(v, 0.f);
    v += __int_as_float(__builtin_amdgcn_update_dpp(0, __float_as_int(v), 0x142, 0xA, 0xF, false));
    v += __int_as_float(__builtin_amdgcn_update_dpp(0, __float_as_int(v), 0x143, 0xC, 0xF, false));
    return v;
}
#define XB_TMO      128
#define XB_XCNT(j)  (256  + 64 * (j))
#define XB_XSUB(j)  (1280 + 64 * (j))
#define XB_XGEN(j)  (2304 + 64 * (j))
#define XB_TOP      3328
#define XB_TOPGEN   3392
#define XCD_BAR_WORDS 3456
#define XB_SPIN_CAP (1u << 18)
__device__ __forceinline__ unsigned xb_ld(unsigned* p)              { return __hip_atomic_load(p, __ATOMIC_RELAXED, __HIP_MEMORY_SCOPE_AGENT); }
__device__ __forceinline__ unsigned xb_add(unsigned* p, unsigned v) { return __hip_atomic_fetch_add(p, v, __ATOMIC_RELAXED, __HIP_MEMORY_SCOPE_AGENT); }
__device__ __forceinline__ unsigned xb_xcc_id() { return (unsigned)__builtin_amdgcn_s_getreg((3 << 11) | 20) & 0xFu; }
#define XB_SPIN(cond, bar) do { unsigned _sp = 0; while (cond) { __builtin_amdgcn_s_sleep(1); \
    if ((++_sp & 255u) == 0u) { if (xb_ld(&(bar)[XB_TMO])) break; if (_sp > XB_SPIN_CAP) { atomicAdd(&(bar)[XB_TMO], 1u); break; } } } } while (0)
struct XcdBarrier { unsigned* bar; unsigned x; volatile LAS unsigned* st; };
__device__ __forceinline__ XcdBarrier xcd_barrier_post(unsigned* bar, volatile LAS unsigned* st, int tid) {
    XcdBarrier b; b.bar = bar; b.x = xb_xcc_id(); b.st = st;
    if (tid == 0) (void)xb_add(&bar[XB_XCNT(b.x)], 1u);
    return b;
}
__device__ __forceinline__ void xcd_barrier_complete(unsigned* bar, unsigned x, unsigned& nloc, unsigned& nx) {
    const unsigned G = gridDim.x * gridDim.y * gridDim.z;
    unsigned sum, cnt, mine, sp = 0u;
    for (;;) {
        sum = 0u; cnt = 0u; mine = 0u;
#pragma unroll
        for (unsigned j = 0; j < 16; ++j) { const unsigned c = xb_ld(&bar[XB_XCNT(j)]); sum += c; cnt += (c > 0u) ? 1u : 0u; mine = (j == x) ? c : mine; }
        if (sum == G) break;
        __builtin_amdgcn_s_sleep(1);
        if ((++sp & 255u) == 0u) { if (xb_ld(&bar[XB_TMO])) break; if (sp > XB_SPIN_CAP) { atomicAdd(&bar[XB_TMO], 1u); break; } }
    }
    nloc = mine > 0u ? mine : 1u; nx = cnt > 0u ? cnt : 1u;
}
__device__ __forceinline__ void xcd_barrier(const XcdBarrier& b, int tid) {
    asm volatile("s_waitcnt vmcnt(0)" ::: "memory");
    __syncthreads();
    if (tid == 0) {
        unsigned* bar = b.bar;
        __builtin_amdgcn_s_waitcnt(0);
        unsigned nloc = b.st[0], nx = b.st[1];
        if (nloc == 0u) { xcd_barrier_complete(bar, b.x, nloc, nx); b.st[0] = nloc; b.st[1] = nx; }
        const unsigned old = xb_add(&bar[XB_XSUB(b.x)], 1u);
        const unsigned gen = old / nloc;
        if (old + 1u == (gen + 1u) * nloc) {
            __builtin_amdgcn_fence(__ATOMIC_RELEASE, "agent");
            asm volatile("s_waitcnt vmcnt(0)" ::: "memory");
            const unsigned og = xb_add(&bar[XB_TOP], 1u);
            const unsigned tg = og / nx;
            if (og + 1u == (tg + 1u) * nx) xb_add(&bar[XB_TOPGEN], 1u);
            else XB_SPIN(xb_ld(&bar[XB_TOPGEN]) == tg, bar);
            __builtin_amdgcn_fence(__ATOMIC_ACQUIRE, "agent");
            xb_add(&bar[XB_XGEN(b.x)], 1u);
            asm volatile("s_waitcnt vmcnt(0)" ::: "memory");
        } else {
            XB_SPIN(xb_ld(&bar[XB_XGEN(b.x)]) == gen, bar);
            __builtin_amdgcn_fence(__ATOMIC_ACQUIRE, "agent");
            asm volatile("s_waitcnt vmcnt(0)" ::: "memory");
        }
    }
    __syncthreads();
}

struct Params { const float* in[27]; float* out; unsigned char* ws; int q_lo, q_hi; };

struct Frame {
    LAS unsigned char* lds;
    int tid, lane, wave;
    const float* const* in;
    float* out; unsigned char* ws;
};
#define WSP(T_, off) ((T_*)(F.ws + (off)))
#define PHASE_IDS(F) do { asm volatile("" : "+v"((F).tid)); (F).lane = (F).tid & 63; (F).wave = __builtin_amdgcn_readfirstlane((F).tid >> 6); } while (0)

__device__ __forceinline__ unsigned pk4_fp8(float a, float b, float c, float d) { int w = 0; w = __builtin_amdgcn_cvt_pk_fp8_f32(a, b, w, false); w = __builtin_amdgcn_cvt_pk_fp8_f32(c, d, w, true); return (unsigned)w; }
__device__ __forceinline__ void tr8_load(f32x4 (&v)[16], const float* src, int ld, int k0, int n0, int lane) {
    const int lr = lane >> 4, lc = (lane & 15) * 4;
#pragma unroll
    for (int i = 0; i < 16; ++i) v[i] = *(const f32x4*)(src + (size_t)(k0 + 16 * lr + i) * ld + n0 + lc);
}
__device__ __forceinline__ void tr8_store(const f32x4 (&v)[16], int k0, unsigned char* dst, int dstK, int drow0, int lane, float scale) {
    const int lr = lane >> 4, lc = (lane & 15) * 4;
#pragma unroll
    for (int j = 0; j < 4; ++j) { u32x4 o;
#pragma unroll
        for (int q = 0; q < 4; ++q) o[q] = pk4_fp8(v[4 * q][j] * scale, v[4 * q + 1][j] * scale, v[4 * q + 2][j] * scale, v[4 * q + 3][j] * scale);
        *(u32x4*)(dst + (size_t)(drow0 + lc + j) * dstK + k0 + 16 * lr) = o; }
}
__device__ __forceinline__ void tr_item8(const float* src, int ld, int k0, int n0, unsigned char* dst, int dstK, int drow0, LAS unsigned char*  , int lane, float scale) {
    f32x4 v[16]; tr8_load(v, src, ld, k0, n0, lane); tr8_store(v, k0, dst, dstK, drow0, lane, scale);
}

__device__ __forceinline__ void tr_item(const float* src, int ld, int k0, int n0, bf16* dst, int dstK, int drow0, LAS bf16* scr, int lane) {
    const int lr = lane >> 4, lc = (lane & 15) * 4;
    f32x4 v[16];
#pragma unroll
    for (int i = 0; i < 16; ++i) v[i] = *(const f32x4*)(src + (size_t)(k0 + 4 * i + lr) * ld + n0 + lc);
#pragma unroll
    for (int i = 0; i < 16; ++i) { const int k = 4 * i + lr;
        scr[(lc + 0) * 66 + k] = (bf16)f2bf(v[i][0]); scr[(lc + 1) * 66 + k] = (bf16)f2bf(v[i][1]); scr[(lc + 2) * 66 + k] = (bf16)f2bf(v[i][2]); scr[(lc + 3) * 66 + k] = (bf16)f2bf(v[i][3]); }
    asm volatile("s_waitcnt lgkmcnt(0)" ::: "memory");
#pragma unroll
    for (int j = 0; j < 8; ++j) { const int n = 8 * j + (lane >> 3), c = (lane & 7) * 8;
        const LAS unsigned* p = (const LAS unsigned*)(scr + n * 66 + c); u32x4 o; o.x = p[0]; o.y = p[1]; o.z = p[2]; o.w = p[3];
        *(u32x4*)(dst + (size_t)(drow0 + n) * dstK + k0 + c) = o; }
    asm volatile("s_waitcnt lgkmcnt(0)" ::: "memory");
}

__device__ __forceinline__ void phase_prologue(Frame& F) {
    PHASE_IDS(F);
    const int gw = blockIdx.x * 8 + F.wave, NGW = gridDim.x * 8;
    LAS bf16* scr = (LAS bf16*)(F.lds + F.wave * 16384);
    { const f32x4* x4 = (const f32x4*)F.in[0]; u32x4* xb = (u32x4*)F.out;
      const size_t n8 = (size_t)T * D / 8, gt = (size_t)blockIdx.x * 512 + F.tid, GT = (size_t)gridDim.x * 512;
      for (size_t i = gt; i < n8; i += 4 * GT) { f32x4 a[4], b[4];
#pragma unroll
          for (int j = 0; j < 4; ++j) { a[j] = x4[2 * (i + j * GT)]; b[j] = x4[2 * (i + j * GT) + 1]; }
#pragma unroll
          for (int j = 0; j < 4; ++j) {
#if !INPROJ_FP8
              u32x4 o; o.x = pk2(a[j].x, a[j].y); o.y = pk2(a[j].z, a[j].w); o.z = pk2(b[j].x, b[j].y); o.w = pk2(b[j].z, b[j].w); xb[i + j * GT] = o;
#else
              constexpr float SC = (float)(1 << FP8_A_SHIFT); u32x2 o8; o8.x = pk4_fp8(a[j].x * SC, a[j].y * SC, a[j].z * SC, a[j].w * SC); o8.y = pk4_fp8(b[j].x * SC, b[j].y * SC, b[j].z * SC, b[j].w * SC);
              ((u32x2*)((unsigned char*)F.out + (size_t)T * 2048))[i + j * GT] = o8;
#endif
          } } }
    constexpr int I_IN = 16 * 112, I_SQ = 16 * 16, I_R = 16 * 4, I_SG = 16 * 4, I_SD = 4 * 16;
    constexpr int NITEMS = I_IN + 3 * I_SQ + I_R + 2 * I_SG + I_SD;
    for (int it = gw; it < NITEMS; it += NGW) {
        int r = it;
        if (r < I_IN) { const int kb = r / 112, nb = r % 112; const int n0d = 64 * nb, n0s = n0d + (n0d >= 5120 ? 16 : 0);
#if INPROJ_FP8
            tr_item8(F.in[1], DIN, 64 * kb, n0s, WSP(unsigned char, WS_WIN), 1024, n0d, (LAS unsigned char*)scr, F.lane, (float)(1 << FP8_W_SHIFT)); continue; } r -= I_IN;
#else
            tr_item(F.in[1], DIN, 64 * kb, n0s, WSP(bf16, WS_WIN), 1024, n0d, scr, F.lane); continue; } r -= I_IN;
#endif
        if (r < I_SQ) { tr_item8(F.in[9], 1024, 64 * (r / 16), 64 * (r % 16), WSP(unsigned char, WS_WA), 1024, 64 * (r % 16), (LAS unsigned char*)scr, F.lane, (float)(1 << FP8_W_SHIFT)); continue; } r -= I_SQ;
        if (r < I_SQ) { tr_item8(F.in[13], 1024, 64 * (r / 16), 64 * (r % 16), WSP(unsigned char, WS_WB), 1024, 64 * (r % 16), (LAS unsigned char*)scr, F.lane, (float)(1 << FP8_W_SHIFT)); continue; } r -= I_SQ;
        if (r < I_SQ) { tr_item8(F.in[14], 1024, 64 * (r / 16), 64 * (r % 16), WSP(unsigned char, WS_WO), 1024, 64 * (r % 16), (LAS unsigned char*)scr, F.lane, (float)(1 << FP8_W_SHIFT)); continue; } r -= I_SQ;
        if (r < I_R) { tr_item(F.in[17], 256, 64 * (r / 4), 64 * (r % 4), WSP(bf16, WS_WR), 1024, 64 * (r % 4), scr, F.lane); continue; } r -= I_R;
        if (r < I_SG) { const int nb = r % 4; tr_item8(F.in[22], 256, 64 * (r / 4), 64 * nb, WSP(unsigned char, WS_WSGU), 1024, (nb >> 1) * 256 + (nb & 1) * 64, (LAS unsigned char*)scr, F.lane, (float)(1 << FP8_W_SHIFT)); continue; } r -= I_SG;
        if (r < I_SG) { const int nb = r % 4; tr_item8(F.in[23], 256, 64 * (r / 4), 64 * nb, WSP(unsigned char, WS_WSGU), 1024, (nb >> 1) * 256 + 128 + (nb & 1) * 64, (LAS unsigned char*)scr, F.lane, (float)(1 << FP8_W_SHIFT)); continue; } r -= I_SG;
        tr_item8(F.in[24], 1024, 64 * (r / 16), 64 * (r % 16), WSP(unsigned char, WS_WSD), 256, 64 * (r % 16), (LAS unsigned char*)scr, F.lane, (float)(1 << FP8_W_SHIFT));
    }
    { const size_t gt = (size_t)blockIdx.x * 512 + F.tid, GT = (size_t)gridDim.x * 512; bf16* wi = WSP(bf16, WS_WIN);
      for (size_t i = gt; i < (size_t)256 * 1024; i += GT) { const int rr = (int)(i >> 10), k = (int)(i & 1023);
#if INPROJ_FP8
          ((unsigned char*)wi)[(size_t)(7168 + rr) * 1024 + k] = rr < 16 ? (unsigned char)(pk4_fp8(F.in[1][(size_t)k * DIN + 5120 + rr] * (float)(1 << FP8_W_SHIFT), 0.f, 0.f, 0.f) & 0xffu) : (unsigned char)0; }
#else
          wi[(size_t)(7168 + rr) * 1024 + k] = rr < 16 ? (bf16)f2bf(F.in[1][(size_t)k * DIN + 5120 + rr]) : (bf16)0; }
#endif
      bf16* lw = WSP(bf16, WS_LRUW);
      for (size_t i = gt; i < (size_t)2 * 65536; i += GT) { const int gate = (int)(i >> 16), r2 = (int)(i & 65535), g = r2 >> 12, n = (r2 >> 6) & 63, k = r2 & 63;
          const float* w = gate ? F.in[6] : F.in[4];
          lw[((size_t)(g * 2 + gate) * 64 + n) * 64 + k] = (bf16)f2bf(w[(size_t)g * 4096 + k * 64 + n]); } }
}

struct EconvItem { const float* src; unsigned char* dst; int ld, k0, n0, dstK, drow0; };
__device__ __forceinline__ EconvItem econv_item(Frame& F, int r) {
    constexpr int I_G = 256 * 16 * 4;
    EconvItem it;
    if (r < 2 * I_G) { const int up = r >= I_G; if (up) r -= I_G; const int e = r >> 6, kb = (r >> 2) & 15, nb = r & 3;
        it.src = F.in[up ? 20 : 19] + (size_t)e * 1024 * 256; it.ld = 256; it.k0 = 64 * kb; it.n0 = 64 * nb; it.dst = WSP(unsigned char, WS_WGU8) + (size_t)e * 512 * 1024; it.dstK = 1024; it.drow0 = (nb >> 1) * 256 + up * 128 + (nb & 1) * 64; }
    else { r -= 2 * I_G; const int e = r >> 6, kb = (r >> 4) & 3, nb = r & 15;
        it.src = F.in[21] + (size_t)e * 256 * 1024; it.ld = 1024; it.k0 = 64 * kb; it.n0 = 64 * nb; it.dst = WSP(unsigned char, WS_WD8) + (size_t)e * 1024 * 256; it.dstK = 256; it.drow0 = 64 * nb; }
    return it;
}
__device__ __forceinline__ void phase_expert_convert(Frame& F) {
    PHASE_IDS(F);
    __syncthreads();
    const int gw = blockIdx.x * 8 + F.wave, NGW = gridDim.x * 8;
    constexpr int NIT = 2 * 256 * 16 * 4 + 256 * 4 * 16; constexpr float SC = (float)(1 << FP8_W_SHIFT);
#pragma unroll 1
    for (int r = gw; r < NIT; r += 2 * NGW) {
        const EconvItem ia = econv_item(F, r); f32x4 va[16]; tr8_load(va, ia.src, ia.ld, ia.k0, ia.n0, F.lane);
        if (r + NGW < NIT) { const EconvItem ib = econv_item(F, r + NGW); f32x4 vb[16]; tr8_load(vb, ib.src, ib.ld, ib.k0, ib.n0, F.lane);
            tr8_store(va, ia.k0, ia.dst, ia.dstK, ia.drow0, F.lane, SC); tr8_store(vb, ib.k0, ib.dst, ib.dstK, ib.drow0, F.lane, SC); }
        else tr8_store(va, ia.k0, ia.dst, ia.dstK, ia.drow0, F.lane, SC);
    }
}

__device__ __forceinline__ int pg_perm_row(int r) { const int rho = r & 31, n = rho >> 4, i = rho & 15; return (r & ~31) + 8 * (i >> 2) + 4 * n + (i & 3); }
struct GUnit { const bf16* A; const bf16* Bt; const int* gat; int pm, pn; };

__device__ __forceinline__ void glds16(const void* g, LAS unsigned char* l) { __builtin_amdgcn_global_load_lds((const unsigned*)g, (LAS unsigned*)l, 16, 0, 0); }

template <class Prov, class Epi>
__device__ __forceinline__ void gemm_phase_simple(LAS unsigned char* lds, const Prov& PV, const Epi& E, int& tid_m) {
    asm volatile("" : "+v"(tid_m)); const int tid = tid_m;
    const int wid = __builtin_amdgcn_readfirstlane(tid >> 6), lane = tid & 63;
    const int wr = wid >> 2, wc = wid & 3, fr = lane & 15, fq = lane >> 4;
    static_assert(!Prov::ATILED && !Prov::FP8, "the simple body has no tiled-A / fp8 path");
    const int nun = PV.count();
    for (int i = 0; Prov::LOCAL ? (i < nun) : (i * (int)gridDim.x + (int)blockIdx.x < nun); ++i) {
        static_assert(!Prov::TABLE || true, ""); GUnit g; if constexpr (Prov::TABLE) { __syncthreads(); if (tid == 0) PV.tab[0] = PV.tab_val(i * (int)gridDim.x + (int)blockIdx.x); __syncthreads(); PV.get(i * (int)gridDim.x + (int)blockIdx.x, g, 0); } else PV.get(Prov::LOCAL ? i : i * (int)gridDim.x + (int)blockIdx.x, g);
        const int r0 = tid >> 2, c8 = (tid & 3) * 8;
        long ra0 = r0, ra1 = r0 + 128;
        if (g.gat) { ra0 = g.gat[r0]; ra1 = g.gat[r0 + 128]; }
        const bf16* pa0 = g.A + ra0 * PV.lda_() + c8; const bf16* pa1 = g.A + ra1 * PV.lda_() + c8;
        const bf16* pb0 = g.Bt + (long)pg_perm_row(r0) * PV.ldb_() + c8; const bf16* pb1 = g.Bt + (long)pg_perm_row(r0 + 128) * PV.ldb_() + c8;
        f32x4 acc[2][2][4][2];
#pragma unroll
        for (int a = 0; a < 2; ++a)
#pragma unroll
            for (int b = 0; b < 2; ++b)
#pragma unroll
                for (int m = 0; m < 4; ++m)
#pragma unroll
                    for (int n = 0; n < 2; ++n) acc[a][b][m][n] = (f32x4){0.f, 0.f, 0.f, 0.f};
        const int nt = PV.kdim() >> 5;
#define GS_STG(t, buf) do { LAS unsigned char* d_ = lds + (buf) * 32768 + wid * 1024; \
        glds16(pa0 + (t) * 32, d_); glds16(pa1 + (t) * 32, d_ + 8192); glds16(pb0 + (t) * 32, d_ + 16384); glds16(pb1 + (t) * 32, d_ + 24576); } while (0)
        GS_STG(0, 0);
        for (int t = 0; t < nt; ++t) {
            const int buf = t & 1;
            asm volatile("s_waitcnt vmcnt(0)" ::: "memory"); __syncthreads();
            if (t + 1 < nt) GS_STG(t + 1, buf ^ 1);
            const LAS unsigned char* sa = lds + buf * 32768; const LAS unsigned char* sb = sa + 16384;
            bf16x8 af[2][4], bq[2][2];
#pragma unroll
            for (int a = 0; a < 2; ++a)
#pragma unroll
                for (int m = 0; m < 4; ++m) af[a][m] = *(const LAS bf16x8*)(sa + (a * 128 + wr * 64 + m * 16 + fr) * 64 + fq * 16);
#pragma unroll
            for (int b = 0; b < 2; ++b)
#pragma unroll
                for (int n = 0; n < 2; ++n) bq[b][n] = *(const LAS bf16x8*)(sb + (b * 128 + wc * 32 + n * 16 + fr) * 64 + fq * 16);
#pragma unroll
            for (int a = 0; a < 2; ++a)
#pragma unroll
                for (int b = 0; b < 2; ++b)
#pragma unroll
                    for (int m = 0; m < 4; ++m)
#pragma unroll
                        for (int n = 0; n < 2; ++n) acc[a][b][m][n] = __builtin_amdgcn_mfma_f32_16x16x32_bf16(bq[b][n], af[a][m], acc[a][b][m][n], 0, 0, 0);
        }
#undef GS_STG
        __syncthreads();
        E(acc, g, wr, wc, fr, fq);
    }
}

constexpr int PG_HTB = 128 * 64 * 2;
__device__ __forceinline__ int pg_lds_byte(int r, int c) { const int st = (r >> 4) * 2 + (c >> 5), rr = r & 15, cc = c & 31, ob = rr * 64 + cc * 2; return st * 1024 + (ob ^ (((ob >> 9) & 1) << 5)); }
__device__ __forceinline__ void pg_stage_rc(int b, int& R, int& C) { const int st = b / 1024, sb = b % 1024, swz = sb ^ (((sb >> 9) & 1) << 5); R = (st >> 1) * 16 + swz / 64; C = (st & 1) * 32 + (swz % 64) / 2; }
__device__ __forceinline__ int pg_order(int L, int nwg) { const int q = nwg / 8, r = nwg % 8, xcd = L % 8, off = L / 8; return (xcd < r ? xcd * (q + 1) : r * (q + 1) + (xcd - r) * q) + off; }

template <class Prov, class Epi, bool ALIGN_EPI, bool SP2>
__device__ __forceinline__ void gemm_phase_pg8(LAS unsigned char* lds, const Prov& PV, const Epi& E, int& tid_m) {
    asm volatile("" : "+v"(tid_m)); const int tid = tid_m;
    __syncthreads();
    if constexpr (Prov::TABLE) {
        const int nun_ = PV.count(); if ((int)blockIdx.x + tid * (int)gridDim.x < nun_ && tid < 256) PV.tab[tid] = PV.tab_val(pg_order(tid * (int)gridDim.x + (int)blockIdx.x, nun_));
        __syncthreads(); }
    const int wid = __builtin_amdgcn_readfirstlane(tid >> 6), lane = tid & 63, wr = wid >> 2, wc = wid & 3, fr = lane & 15, fq = lane >> 4;
    const int nun = PV.count(), G = gridDim.x, c = blockIdx.x;
#define PG8_HAS(i) (Prov::LOCAL ? ((i) < nun) : ((i) * G + c < nun))
#define PG8_UNIT(i) (Prov::LOCAL ? (i) : pg_order((i) * G + c, nun))
    if (!PG8_HAS(0)) return;
    int R_[2], C_[2];
#pragma unroll
    for (int i = 0; i < 2; ++i) pg_stage_rc(tid * 16 + i * 8192, R_[i], C_[i]);
    const unsigned ldsw = (unsigned)wid * 1024u;
    const int aoff = pg_lds_byte(wr * 64 + fr, fq * 8), boff = pg_lds_byte(wc * 32 + fr, fq * 8);
#define PG8_SA(b, h) (((b) * 2 + (h)) * PG_HTB)
#define PG8_SB(b, h) ((4 + (b) * 2 + (h)) * PG_HTB)
#define PG8_STAGE(bufoff, gbase, o0, o1) do { \
        __builtin_amdgcn_global_load_lds((const unsigned*)((const char*)(gbase) + (o0)), (LAS unsigned*)(lds + (bufoff) + ldsw), 16, 0, 0); \
        __builtin_amdgcn_global_load_lds((const unsigned*)((const char*)(gbase) + (o1)), (LAS unsigned*)(lds + (bufoff) + ldsw + 8192), 16, 0, 0); } while (0)
#define PG8_STA(bufoff, gbase, h, NX) do { if constexpr (Prov::GATHER) { PG8_STAGE(bufoff, gbase, (NX) ? nao[h][0] : cao[h][0], (NX) ? nao[h][1] : cao[h][1]); } \
        else { PG8_STAGE(bufoff, (gbase) + (h) * hstepA, vA[0], vA[1]); } } while (0)
#define PG8_STB(bufoff, gbase, h) PG8_STAGE(bufoff, (gbase) + (h) * hstepB, vB[0], vB[1])
#define PG8_LDA(dst, b, h) do { _Pragma("unroll") for (int m = 0; m < 4; ++m) _Pragma("unroll") for (int k = 0; k < 2; ++k) dst[m][k] = *(const LAS v4i*)(lds + PG8_SA(b, h) + aoff + m * 2048 + k * 1024); } while (0)
#define PG8_LDB(dst, b, h) do { _Pragma("unroll") for (int n = 0; n < 2; ++n) _Pragma("unroll") for (int k = 0; k < 2; ++k) dst[n][k] = *(const LAS v4i*)(lds + PG8_SB(b, h) + boff + n * 2048 + k * 1024); } while (0)
#define PG8_MMA(ai, bj, At, Bt) do { __builtin_amdgcn_s_setprio(1); _Pragma("unroll") for (int m = 0; m < 4; ++m) _Pragma("unroll") for (int n = 0; n < 2; ++n) _Pragma("unroll") for (int k = 0; k < 2; ++k) \
        acc[ai][bj][m][n] = __builtin_amdgcn_mfma_f32_16x16x32_bf16(__builtin_bit_cast(bf16x8, Bt[n][k]), __builtin_bit_cast(bf16x8, At[m][k]), acc[ai][bj][m][n], 0, 0, 0); __builtin_amdgcn_s_setprio(0); } while (0)
#define PG8_MMA8(ai, bj, At, Bt) do { __builtin_amdgcn_s_setprio(1); _Pragma("unroll") for (int m = 0; m < 4; ++m) _Pragma("unroll") for (int n = 0; n < 2; ++n) { \
        const v8i bw_ = __builtin_shufflevector(Bt[n][0], Bt[n][1], 0, 1, 2, 3, 4, 5, 6, 7), aw_ = __builtin_shufflevector(At[m][0], At[m][1], 0, 1, 2, 3, 4, 5, 6, 7); \
        asm volatile("s_nop 1\n\tv_mfma_scale_f32_16x16x128_f8f6f4 %0, %1, %2, %0, %3, %4 op_sel_hi:[0,0,0]" : "+v"(acc[ai][bj][m][n]) : "v"(bw_), "v"(aw_), "v"(fp8_scale_w), "v"(fp8_scale_a)); } \
        __builtin_amdgcn_s_setprio(0); } while (0)
#define PG8_MM(ai, bj, At, Bt) do { if constexpr (Prov::FP8) PG8_MMA8(ai, bj, At, Bt); else PG8_MMA(ai, bj, At, Bt); } while (0)
#define PG8_WAIT_V(n) asm volatile("s_waitcnt vmcnt(" #n ")" ::: "memory")
#define PG8_WAIT_L(n) asm volatile("s_waitcnt lgkmcnt(" #n ")" ::: "memory")
#define PG8_BAR __builtin_amdgcn_s_barrier()
#define PG8_SCHED __builtin_amdgcn_sched_barrier(0)
#define PG8_OFFS(g, AO) do { _Pragma("unroll") for (int h = 0; h < 2; ++h) _Pragma("unroll") for (int i = 0; i < 2; ++i) \
        AO[h][i] = (unsigned)(g).gat[h * 128 + R_[i]] * (unsigned)(lda * 2) + (unsigned)(C_[i] * 2); } while (0)
    GUnit cur, nxt; int ui = 0;
    PV.get(PG8_UNIT(0), cur, 0);
    f32x4 acc[2][2][4][2];
#pragma unroll
    for (int a = 0; a < 2; ++a)
#pragma unroll
        for (int b = 0; b < 2; ++b)
#pragma unroll
            for (int m = 0; m < 4; ++m)
#pragma unroll
                for (int n = 0; n < 2; ++n) acc[a][b][m][n] = (f32x4){0.f, 0.f, 0.f, 0.f};
    v4i At[4][2], B0[2][2], B1[2][2];
    const int fp8_scale_w = 0x01010101 * (127 - FP8_W_SHIFT), fp8_scale_a = 0x01010101 * (127 - FP8_A_SHIFT);
    unsigned cao[2][2], nao[2][2], vA[2], vB[2];
    const int lda = PV.lda_(), ldb = PV.ldb_();
    const size_t hstepA = (size_t)128 * lda * 2, hstepB = (size_t)128 * ldb * 2;
#pragma unroll
    for (int i = 0; i < 2; ++i) { vA[i] = (unsigned)(R_[i] * lda + C_[i]) * 2u; vB[i] = (unsigned)(pg_perm_row(R_[i]) * ldb + C_[i]) * 2u; }
    if constexpr (Prov::GATHER) PG8_OFFS(cur, cao);
    const char* cA = (const char*)cur.A; const char* cB = (const char*)cur.Bt;
    const size_t kstep = 128;
    if constexpr (SP2) {
        PG8_STB(PG8_SB(0, 0), cB, 0); PG8_STB(PG8_SB(0, 1), cB, 1); PG8_STA(PG8_SA(0, 0), cA, 0, false); PG8_STA(PG8_SA(0, 1), cA, 1, false);
        if (wr == 1) PG8_BAR;
        PG8_WAIT_V(2); PG8_BAR;
        PG8_STB(PG8_SB(1, 0), cB + kstep, 0); PG8_STA(PG8_SA(1, 0), cA + kstep, 0, false); PG8_STB(PG8_SB(1, 1), cB + kstep, 1);
        PG8_WAIT_V(6); PG8_BAR;
    } else {
        PG8_STB(PG8_SB(0, 0), cB, 0); PG8_STA(PG8_SA(0, 0), cA, 0, false); PG8_STB(PG8_SB(0, 1), cB, 1); PG8_STA(PG8_SA(0, 1), cA, 1, false);
        if (wr == 1) PG8_BAR;
        PG8_WAIT_V(4); PG8_BAR;
        PG8_STB(PG8_SB(1, 0), cB + kstep, 0); PG8_STA(PG8_SA(1, 0), cA + kstep, 0, false); PG8_STB(PG8_SB(1, 1), cB + kstep, 1);
        PG8_WAIT_V(6); PG8_BAR;
    }
    for (;;) {
        const bool has_next = PG8_HAS(ui + 1);
        if (has_next) { PV.get(PG8_UNIT(ui + 1), nxt, ui + 1); if constexpr (Prov::GATHER) PG8_OFFS(nxt, nao); }
        else if constexpr (Prov::GATHER) {
#pragma unroll
            for (int h = 0; h < 2; ++h)
#pragma unroll
                for (int i = 0; i < 2; ++i) nao[h][i] = cao[h][i]; }
        const char* nA = has_next ? (const char*)nxt.A : cA; const char* nB = has_next ? (const char*)nxt.Bt : cB;
        const int nt = PV.kdim() >> 6;
#pragma unroll 1
        for (int t = 0; t < nt; t += 2) {
            const bool last = (t == nt - 2);
#define PG8_KOFF(t_) (Prov::ATILED ? ((size_t)((t_) >> 2) * 131072 + (size_t)((t_) & 3) * 128) : (size_t)(t_) * kstep)
            const char* a1 = cA + PG8_KOFF(t + 1);
            const char* a2 = last ? nA : cA + PG8_KOFF(t + 2); const char* b2 = last ? nB : cB + (size_t)(t + 2) * kstep;
            const char* a3 = a2 + kstep; const char* b3 = b2 + kstep;
            if constexpr (SP2) {
            PG8_LDB(B0, 0, 0); PG8_LDB(B1, 0, 1); PG8_SCHED; PG8_LDA(At, 0, 0); PG8_STA(PG8_SA(1, 1), a1, 1, false);
            PG8_WAIT_V(8); PG8_WAIT_L(0); PG8_BAR; PG8_MM(0, 0, At, B0); PG8_MM(0, 1, At, B1); PG8_BAR; PG8_SCHED;
            PG8_LDA(At, 0, 1); PG8_STB(PG8_SB(0, 0), b2, 0); PG8_STB(PG8_SB(0, 1), b2, 1); PG8_STA(PG8_SA(0, 0), a2, 0, last);
            PG8_WAIT_V(8); PG8_WAIT_L(0); PG8_BAR; PG8_MM(1, 0, At, B0); PG8_MM(1, 1, At, B1); PG8_BAR; PG8_SCHED;
            PG8_LDB(B0, 1, 0); PG8_LDB(B1, 1, 1); PG8_SCHED; PG8_LDA(At, 1, 0); PG8_STA(PG8_SA(0, 1), a2, 1, last);
            PG8_WAIT_V(8); PG8_WAIT_L(0); PG8_BAR; PG8_MM(0, 0, At, B0); PG8_MM(0, 1, At, B1); PG8_BAR; PG8_SCHED;
            PG8_LDA(At, 1, 1); PG8_STB(PG8_SB(1, 0), b3, 0); PG8_STB(PG8_SB(1, 1), b3, 1); PG8_STA(PG8_SA(1, 0), a3, 0, last);
            PG8_WAIT_V(8); PG8_WAIT_L(0); PG8_BAR; PG8_MM(1, 0, At, B0); PG8_MM(1, 1, At, B1); PG8_BAR; PG8_SCHED;
            } else {
            PG8_LDB(B0, 0, 0); PG8_SCHED; PG8_LDA(At, 0, 0); PG8_STA(PG8_SA(1, 1), a1, 1, false);
            PG8_WAIT_L(8); PG8_BAR; PG8_WAIT_L(0); PG8_MM(0, 0, At, B0); PG8_BAR; PG8_SCHED;
            PG8_LDB(B1, 0, 1); PG8_STB(PG8_SB(0, 0), b2, 0);
            PG8_BAR; PG8_WAIT_L(0); PG8_MM(0, 1, At, B1); PG8_BAR;
            PG8_LDA(At, 0, 1); PG8_STA(PG8_SA(0, 0), a2, 0, last);
            PG8_BAR; PG8_WAIT_L(0); PG8_MM(1, 0, At, B0); PG8_BAR; PG8_SCHED;
            PG8_STB(PG8_SB(0, 1), b2, 1);
            PG8_WAIT_V(6); PG8_BAR; PG8_MM(1, 1, At, B1); PG8_BAR;
            PG8_LDB(B0, 1, 0); PG8_SCHED; PG8_LDA(At, 1, 0); PG8_STA(PG8_SA(0, 1), a2, 1, last);
            PG8_WAIT_L(8); PG8_BAR; PG8_WAIT_L(0); PG8_MM(0, 0, At, B0); PG8_BAR; PG8_SCHED;
            PG8_LDB(B1, 1, 1); PG8_STB(PG8_SB(1, 0), b3, 0);
            PG8_BAR; PG8_WAIT_L(0); PG8_MM(0, 1, At, B1); PG8_BAR;
            PG8_LDA(At, 1, 1); PG8_STA(PG8_SA(1, 0), a3, 0, last);
            PG8_BAR; PG8_WAIT_L(0); PG8_MM(1, 0, At, B0); PG8_BAR; PG8_SCHED;
            PG8_STB(PG8_SB(1, 1), b3, 1);
            PG8_WAIT_V(6); PG8_BAR; PG8_MM(1, 1, At, B1); PG8_BAR;
            }
        }
        if constexpr (Prov::FP8) asm volatile("s_nop 15\n\ts_nop 15" ::: "memory");
        if constexpr (ALIGN_EPI) { if (wr == 0) PG8_BAR; }
        { asm volatile("" : "+v"(tid_m));
          E(acc, cur, wr, wc, tid_m & 15, (tid_m & 63) >> 4); }
        if (!has_next) break;
#pragma unroll
        for (int a = 0; a < 2; ++a)
#pragma unroll
            for (int b = 0; b < 2; ++b)
#pragma unroll
                for (int m = 0; m < 4; ++m)
#pragma unroll
                    for (int n = 0; n < 2; ++n) acc[a][b][m][n] = (f32x4){0.f, 0.f, 0.f, 0.f};
        cur = nxt; cA = nA; cB = nB; ++ui;
        if constexpr (Prov::GATHER) {
#pragma unroll
            for (int h = 0; h < 2; ++h)
#pragma unroll
                for (int i = 0; i < 2; ++i) cao[h][i] = nao[h][i]; }
        if constexpr (ALIGN_EPI) { if (wr == 1) PG8_BAR; }
    }
    PG8_WAIT_V(0);
    if constexpr (!ALIGN_EPI) { if (wr == 0) PG8_BAR; }
    PG8_BAR;
#undef PG8_SA
#undef PG8_SB
#undef PG8_STAGE
#undef PG8_STA
#undef PG8_STB
#undef PG8_LDA
#undef PG8_LDB
#undef PG8_MMA
#undef PG8_MMA8
#undef PG8_MM
#undef PG8_WAIT_V
#undef PG8_WAIT_L
#undef PG8_BAR
#undef PG8_SCHED
#undef PG8_OFFS
#undef PG8_KOFF
#undef PG8_HAS
#undef PG8_UNIT
}

#define EPI_FOR_ROWS for (int ai = 0; ai < 2; ++ai) for (int m = 0; m < 4; ++m)
#define EPI_ROW (ai * 128 + wr * 64 + m * 16 + fr)
#define EPI_COL8 (bj * 128 + wc * 32 + 8 * fq)
typedef f32x4 Acc[2][2][4][2];
__device__ __forceinline__ u32x4 pack8(const f32x4 a, const f32x4 b) { u32x4 w; w.x = cvt_pk_bf16(a[0], a[1]); w.y = cvt_pk_bf16(a[2], a[3]); w.z = cvt_pk_bf16(b[0], b[1]); w.w = cvt_pk_bf16(b[2], b[3]); return w; }
__device__ __forceinline__ void unpack8(const u32x4 w, f32x4& a, f32x4& b) { a[0] = lo16(w.x); a[1] = hi16(w.x); a[2] = lo16(w.y); a[3] = hi16(w.y); b[0] = lo16(w.z); b[1] = hi16(w.z); b[2] = lo16(w.w); b[3] = hi16(w.w); }
__device__ __forceinline__ f32x4 sig4(const f32x4 x) { f32x4 r; r[0] = sigmoidf_(x[0]); r[1] = sigmoidf_(x[1]); r[2] = sigmoidf_(x[2]); r[3] = sigmoidf_(x[3]); return r; }
__device__ __forceinline__ f32x4 silu4(const f32x4 x) { f32x4 r; r[0] = siluf_(x[0]); r[1] = siluf_(x[1]); r[2] = siluf_(x[2]); r[3] = siluf_(x[3]); return r; }

struct ProvDense {
    static constexpr bool GATHER = false, LOCAL = false, ATILED = false, TABLE = false, FP8 = false;
    const bf16* A; const bf16* Bt; int lda, K, nM, nN;
    __device__ __forceinline__ int count() const { return nM * nN; }
    __device__ __forceinline__ void get(int u, GUnit& g, int = 0) const { const int nig = 8 * nN, gid = u / nig, fm = gid * 8, gsz = (nM - fm) < 8 ? (nM - fm) : 8, loc = u % nig; g.pm = fm + loc % gsz; g.pn = loc / gsz; g.A = A + (size_t)g.pm * 256 * lda; g.Bt = Bt + (size_t)g.pn * 256 * K; g.gat = nullptr; }
    __device__ __forceinline__ int lda_() const { return lda; }
    __device__ __forceinline__ int ldb_() const { return K; }
    __device__ __forceinline__ int kdim() const { return K; }
};
template <bool PANEL>
struct ProvTiledA {
    static constexpr bool GATHER = false, LOCAL = PANEL, ATILED = true, TABLE = false, FP8 = false;
    const bf16* P; int pn0; const bf16* Bt; int nM, nN;
    __device__ __forceinline__ int count() const { if (PANEL) { const int np = (nM - (int)blockIdx.x + (int)gridDim.x - 1) / (int)gridDim.x; return np * nN; } return nM * nN; }
    __device__ __forceinline__ void get(int u, GUnit& g, int = 0) const {
        if (PANEL) { g.pm = (int)blockIdx.x + (u / nN) * (int)gridDim.x; g.pn = u % nN; }
        else { const int nig = 8 * nN, gid = u / nig, fm = gid * 8, gsz = (nM - fm) < 8 ? (nM - fm) : 8, loc = u % nig; g.pm = fm + loc % gsz; g.pn = loc / gsz; }
        g.A = P + (((size_t)g.pm * NPT + pn0) << 16); g.Bt = Bt + (size_t)g.pn * 256 * 1024; g.gat = nullptr; }
    __device__ __forceinline__ int lda_() const { return 256; }
    __device__ __forceinline__ int ldb_() const { return 1024; }
    __device__ __forceinline__ int kdim() const { return 1024; }
};
struct ProvDense8 {
    static constexpr bool GATHER = false, LOCAL = false, ATILED = false, TABLE = false, FP8 = true;
    const unsigned char* A; const unsigned char* Bt; int K, nM, nN;
    __device__ __forceinline__ int count() const { return nM * nN; }
    __device__ __forceinline__ void get(int u, GUnit& g, int = 0) const { const int nig = 8 * nN, gid = u / nig, fm = gid * 8, gsz = (nM - fm) < 8 ? (nM - fm) : 8, loc = u % nig; g.pm = fm + loc % gsz; g.pn = loc / gsz; g.A = (const bf16*)(A + (size_t)g.pm * 256 * K); g.Bt = (const bf16*)(Bt + (size_t)g.pn * 256 * K); g.gat = nullptr; }
    __device__ __forceinline__ int lda_() const { return K / 2; }
    __device__ __forceinline__ int ldb_() const { return K / 2; }
    __device__ __forceinline__ int kdim() const { return K / 2; }
};
struct ProvPanel {
    static constexpr bool GATHER = false, LOCAL = true, ATILED = false, TABLE = false, FP8 = false;
    const bf16* A; const bf16* Bt; int lda, K, nM, nN;
    __device__ __forceinline__ int count() const { const int np = (nM - (int)blockIdx.x + (int)gridDim.x - 1) / (int)gridDim.x; return np * nN; }
    __device__ __forceinline__ void get(int u, GUnit& g, int = 0) const { g.pm = (int)blockIdx.x + (u / nN) * (int)gridDim.x; g.pn = u % nN; g.A = A + (size_t)g.pm * 256 * lda; g.Bt = Bt + (size_t)g.pn * 256 * K; g.gat = nullptr; }
    __device__ __forceinline__ int lda_() const { return lda; }
    __device__ __forceinline__ int ldb_() const { return K; }
    __device__ __forceinline__ int kdim() const { return K; }
};
constexpr int PG_TAB_OFF = 131072 + 1024;
struct ProvPanel8 {
    static constexpr bool GATHER = false, LOCAL = true, ATILED = false, TABLE = false, FP8 = true;
    const unsigned char* A; const unsigned char* Bt; int K, nM, nN, pa;
    __device__ __forceinline__ int count() const { const int np = (nM - (int)blockIdx.x + (int)gridDim.x - 1) / (int)gridDim.x; return np * nN; }
    __device__ __forceinline__ void get(int u, GUnit& g, int = 0) const { g.pm = (int)blockIdx.x + (u / nN) * (int)gridDim.x; g.pn = u % nN; g.A = (const bf16*)(A + (size_t)g.pm * pa); g.Bt = (const bf16*)(Bt + (size_t)g.pn * 256 * K); g.gat = nullptr; }
    __device__ __forceinline__ int lda_() const { return K / 2; }
    __device__ __forceinline__ int ldb_() const { return K / 2; }
    __device__ __forceinline__ int kdim() const { return K / 2; }
};
struct ProvGateUp {
    static constexpr bool GATHER = true, LOCAL = false, ATILED = false, TABLE = true, FP8 = true;
    const unsigned char* H8; const unsigned char* Wgu; const int* stok; const int* tile_e; int ntiles; LAS int* tab;
    __device__ __forceinline__ int count() const { return ntiles * 2; }
    __device__ __forceinline__ int tab_val(int u) const { return tile_e[u >> 1]; }
    __device__ __forceinline__ void get(int u, GUnit& g, int li) const { g.pm = u >> 1; g.pn = u & 1; const int e = tab[li]; g.A = (const bf16*)H8; g.gat = stok + (size_t)g.pm * 256; g.Bt = (const bf16*)(Wgu + ((size_t)e * 2 + g.pn) * 256 * 1024); }
    __device__ __forceinline__ int lda_() const { return 512; }
    __device__ __forceinline__ int ldb_() const { return 512; }
    __device__ __forceinline__ int kdim() const { return 512; }
};
struct ProvDown {
    static constexpr bool GATHER = false, LOCAL = false, ATILED = false, TABLE = true, FP8 = true;
    const unsigned char* Act; const unsigned char* Wd; const int* tile_e; int ntiles, hf; LAS int* tab;
    __device__ __forceinline__ int count() const { return ntiles * 2; }
    __device__ __forceinline__ int tab_val(int u) const { return tile_e[u >> 1]; }
    __device__ __forceinline__ void get(int u, GUnit& g, int li) const { g.pm = u >> 1; g.pn = 2 * hf + (u & 1); const int e = tab[li]; g.A = (const bf16*)(Act + (size_t)g.pm * 256 * 256); g.gat = nullptr; g.Bt = (const bf16*)(Wd + ((size_t)e * 1024 + g.pn * 256) * 256); }
    __device__ __forceinline__ int lda_() const { return 128; }
    __device__ __forceinline__ int ldb_() const { return 128; }
    __device__ __forceinline__ int kdim() const { return 128; }
};

constexpr int EPI_BB_OFF = 131072 + 2048, EPI_BB_WAVE = 2048;
static_assert(EPI_BB_OFF + 8 * EPI_BB_WAVE <= MISC_OFF, "bounce buffers");
#define EPI_BB(lds_) ((lds_) + EPI_BB_OFF + (wr * 4 + wc) * EPI_BB_WAVE)
#define EPI_LANE (fq * 16 + fr)
__device__ __forceinline__ u32x4 bb_out64(LAS unsigned char* bb, int fr, int fq, u32x4 v) { *(LAS u32x4*)(bb + fr * 64 + fq * 16) = v; return *(const LAS u32x4*)(bb + (fq * 16 + fr) * 16); }
__device__ __forceinline__ u32x4 bb_in64(LAS unsigned char* bb, int fr, int fq, u32x4 v) { *(LAS u32x4*)(bb + (fq * 16 + fr) * 16) = v; return *(const LAS u32x4*)(bb + fr * 64 + fq * 16); }
__device__ __forceinline__ void bb_out128(LAS unsigned char* bb, int fr, int fq, f32x4 a, f32x4 b, f32x4& o0, f32x4& o1) {
    *(LAS f32x4*)(bb + fr * 128 + fq * 32) = a; *(LAS f32x4*)(bb + fr * 128 + fq * 32 + 16) = b; o0 = *(const LAS f32x4*)(bb + (fq * 16 + fr) * 16); o1 = *(const LAS f32x4*)(bb + 1024 + (fq * 16 + fr) * 16); }
__device__ __forceinline__ void bb_in128(LAS unsigned char* bb, int fr, int fq, f32x4 o0, f32x4 o1, f32x4& a, f32x4& b) {
    *(LAS f32x4*)(bb + (fq * 16 + fr) * 16) = o0; *(LAS f32x4*)(bb + 1024 + (fq * 16 + fr) * 16) = o1; a = *(const LAS f32x4*)(bb + fr * 128 + fq * 32); b = *(const LAS f32x4*)(bb + fr * 128 + fq * 32 + 16); }

constexpr float GATE8_SC = 256.0f;
struct EpiInProj { bf16* P; float* GL; LAS unsigned char* lds;
    __device__ __forceinline__ void operator()(const Acc& acc, const GUnit& g, int wr, int wc, int fr, int fq) const {
        LAS unsigned char* bb = EPI_BB(lds); const int l = EPI_LANE;
        if (g.pn >= C_GTA / 256 && g.pn < 28) {
            unsigned char* tile8 = (unsigned char*)P + (((size_t)g.pm * NPT + g.pn) << 17);
#pragma unroll
            EPI_FOR_ROWS { unsigned char* rowp = tile8 + (ai * 128 + wr * 64 + m * 16 + ((l & 31) >> 1)) * 256 + wc * 32 + (l & 1) * 16;
#pragma unroll
                for (int bj = 0; bj < 2; ++bj) { const f32x4 r0 = sig4(acc[ai][bj][m][0]) * GATE8_SC, r1 = sig4(acc[ai][bj][m][1]) * GATE8_SC;
                    u32x2 w; w.x = pk4_fp8(r0[0], r0[1], r0[2], r0[3]); w.y = pk4_fp8(r1[0], r1[1], r1[2], r1[3]);
                    *(LAS u32x2*)(bb + fr * 32 + fq * 8) = w;
                    const u32x4 o = *(const LAS u32x4*)(bb + (l & 31) * 16);
                    if (l < 32) *(u32x4*)(rowp + bj * 128) = o; } }
        } else if (g.pn < 28) {
            const bool ge = (g.pn >= C_GA / 256) && (g.pn < C_Q / 256), si = (g.pn >= C_R / 256) && (g.pn < C_GTA / 256);
#pragma unroll
            EPI_FOR_ROWS { bf16* rowp = P + (((size_t)g.pm * NPT + g.pn) << 16) + (ai * 128 + wr * 64 + m * 16 + (l >> 2)) * 256 + wc * 32 + 8 * (l & 3);
#pragma unroll
                for (int bj = 0; bj < 2; ++bj) { f32x4 v0 = acc[ai][bj][m][0], v1 = acc[ai][bj][m][1];
                    if (ge) { v0[0] = gelu_tanh(v0[0]); v0[1] = gelu_tanh(v0[1]); v0[2] = gelu_tanh(v0[2]); v0[3] = gelu_tanh(v0[3]); v1[0] = gelu_tanh(v1[0]); v1[1] = gelu_tanh(v1[1]); v1[2] = gelu_tanh(v1[2]); v1[3] = gelu_tanh(v1[3]); }
                    if (si) { v0 = silu4(v0); v1 = silu4(v1); }
                    *(u32x4*)(rowp + bj * 128) = bb_out64(bb, fr, fq, pack8(v0, v1)); } }
        } else if (wc == 0 && fq < 2) {
#pragma unroll
            EPI_FOR_ROWS { float* rowp = GL + ((size_t)g.pm * 256 + EPI_ROW) * 16 + 8 * fq; *(f32x4*)rowp = acc[ai][0][m][0]; *(f32x4*)(rowp + 4) = acc[ai][0][m][1]; }
        }
    } };
struct EpiGateMul {
    const bf16* P; int gcol; const unsigned char* base; bf16* out; unsigned char* out8; int opitch; LAS unsigned char* lds;
    __device__ __forceinline__ void operator()(const Acc& acc, const GUnit& g, int wr, int wc, int fr, int fq) const {
        LAS unsigned char* bb = EPI_BB(lds); const int l = EPI_LANE;
        const unsigned char* tile8 = (const unsigned char*)P + (((size_t)g.pm * NPT + (gcol >> 8) + g.pn) << 17);
#pragma unroll
        for (int ai = 0; ai < 2; ++ai)
#pragma unroll
          for (int mh = 0; mh < 2; ++mh) {
            u32x4 gt[2][2], bs[2][2];
#pragma unroll
            for (int m2 = 0; m2 < 2; ++m2)
#pragma unroll
                for (int bj = 0; bj < 2; ++bj) { const int m = 2 * mh + m2; const size_t row = (size_t)g.pm * 256 + ai * 128 + wr * 64 + m * 16 + (l >> 2); const int col = g.pn * 256 + bj * 128 + wc * 32 + 8 * (l & 3);
                    gt[m2][bj] = *(const u32x4*)(tile8 + (ai * 128 + wr * 64 + m * 16 + ((l & 31) >> 1)) * 256 + bj * 128 + wc * 32 + (l & 1) * 16);
                    if (base) bs[m2][bj] = *(const u32x4*)(base + (size_t)g.pm * H8_PANEL + (ai * 128 + wr * 64 + m * 16 + ((l & 31) >> 1)) * 1024 + g.pn * 256 + bj * 128 + wc * 32 + (l & 1) * 16); }
#pragma unroll
            for (int m2 = 0; m2 < 2; ++m2)
#pragma unroll
                for (int bj = 0; bj < 2; ++bj) { const int m = 2 * mh + m2; const size_t row = (size_t)g.pm * 256 + ai * 128 + wr * 64 + m * 16 + (l >> 2); const int col = g.pn * 256 + bj * 128 + wc * 32 + 8 * (l & 3);
                    *(LAS u32x4*)(bb + (l & 31) * 16) = gt[m2][bj]; const u32x2 gw = *(const LAS u32x2*)(bb + fr * 32 + fq * 8);
                    const f32x2_t a0 = __builtin_amdgcn_cvt_pk_f32_fp8((int)gw.x, false), a1 = __builtin_amdgcn_cvt_pk_f32_fp8((int)gw.x, true), a2 = __builtin_amdgcn_cvt_pk_f32_fp8((int)gw.y, false), a3 = __builtin_amdgcn_cvt_pk_f32_fp8((int)gw.y, true);
                    f32x4 r0 = (f32x4){a0.x, a0.y, a1.x, a1.y} * (1.0f / GATE8_SC) * acc[ai][bj][m][0], r1 = (f32x4){a2.x, a2.y, a3.x, a3.y} * (1.0f / GATE8_SC) * acc[ai][bj][m][1];
                    if (base) { *(LAS u32x4*)(bb + (l & 31) * 16) = bs[m2][bj]; const u32x2 bw = *(const LAS u32x2*)(bb + fr * 32 + fq * 8);
                        const f32x2_t c0 = __builtin_amdgcn_cvt_pk_f32_fp8((int)bw.x, false), c1 = __builtin_amdgcn_cvt_pk_f32_fp8((int)bw.x, true), c2 = __builtin_amdgcn_cvt_pk_f32_fp8((int)bw.y, false), c3 = __builtin_amdgcn_cvt_pk_f32_fp8((int)bw.y, true);
                        r0 += (f32x4){c0.x, c0.y, c1.x, c1.y} * (1.0f / (float)(1 << FP8_A_SHIFT)); r1 += (f32x4){c2.x, c2.y, c3.x, c3.y} * (1.0f / (float)(1 << FP8_A_SHIFT)); }
                    if (out8) { constexpr float SC = (float)(1 << FP8_A_SHIFT); u32x2 w8; w8.x = pk4_fp8(r0[0] * SC, r0[1] * SC, r0[2] * SC, r0[3] * SC); w8.y = pk4_fp8(r1[0] * SC, r1[1] * SC, r1[2] * SC, r1[3] * SC);
                        *(LAS u32x2*)(bb + fr * 32 + fq * 8) = w8; const u32x4 o = *(const LAS u32x4*)(bb + (l & 31) * 16);
                        if (l < 32) *(u32x4*)(out8 + (size_t)g.pm * opitch + (ai * 128 + wr * 64 + m * 16 + ((l & 31) >> 1)) * 1024 + g.pn * 256 + bj * 128 + wc * 32 + (l & 1) * 16) = o; }
                    else *(u32x4*)(out + row * 1024 + col) = bb_out64(bb, fr, fq, pack8(r0, r1)); }
          }
    } };
struct EpiHpre { const float* x; bf16* hp; LAS unsigned char* lds;
    __device__ __forceinline__ void operator()(const Acc& acc, const GUnit& g, int wr, int wc, int fr, int fq) const {
        LAS unsigned char* bb = EPI_BB(lds); const int l = EPI_LANE;
#pragma unroll
        for (int ai = 0; ai < 2; ++ai)
#pragma unroll
            for (int mh = 0; mh < 2; ++mh) {
                f32x4 xv[2][2][2];
#pragma unroll
                for (int m2 = 0; m2 < 2; ++m2)
#pragma unroll
                    for (int bj = 0; bj < 2; ++bj) { const float* xp = x + ((size_t)g.pm * 256 + ai * 128 + wr * 64 + (2 * mh + m2) * 16) * 1024 + g.pn * 256 + bj * 128 + wc * 32;
                        xv[m2][bj][0] = *(const f32x4*)(xp + (size_t)(l >> 3) * 1024 + 4 * (l & 7)); xv[m2][bj][1] = *(const f32x4*)(xp + (size_t)(8 + (l >> 3)) * 1024 + 4 * (l & 7)); }
#pragma unroll
                for (int m2 = 0; m2 < 2; ++m2)
#pragma unroll
                    for (int bj = 0; bj < 2; ++bj) { const int m = 2 * mh + m2; f32x4 x0, x1; bb_in128(bb, fr, fq, xv[m2][bj][0], xv[m2][bj][1], x0, x1);
                        *(u32x4*)(hp + ((size_t)g.pm * 256 + ai * 128 + wr * 64 + m * 16 + (l >> 2)) * 1024 + g.pn * 256 + bj * 128 + wc * 32 + 8 * (l & 3)) = bb_out64(bb, fr, fq, pack8(x0 * DN_ALPHA + acc[ai][bj][m][0], x1 * DN_ALPHA + acc[ai][bj][m][1])); }
            }
    } };
struct EpiF32 { float* C; int ldc; LAS unsigned char* lds;
    __device__ __forceinline__ void operator()(const Acc& acc, const GUnit& g, int wr, int wc, int fr, int fq) const {
        LAS unsigned char* bb = EPI_BB(lds); const int l = EPI_LANE;
#pragma unroll
        EPI_FOR_ROWS {
#pragma unroll
            for (int bj = 0; bj < 2; ++bj) { f32x4 o0, o1; bb_out128(bb, fr, fq, acc[ai][bj][m][0], acc[ai][bj][m][1], o0, o1);
                float* cp = C + ((size_t)g.pm * 256 + ai * 128 + wr * 64 + m * 16) * ldc + g.pn * 256 + bj * 128 + wc * 32;
                *(f32x4*)(cp + (size_t)(l >> 3) * ldc + 4 * (l & 7)) = o0; *(f32x4*)(cp + (size_t)(8 + (l >> 3)) * ldc + 4 * (l & 7)) = o1; } }
    } };
struct EpiSwiglu { bf16* out; LAS unsigned char* lds;
    __device__ __forceinline__ void operator()(const Acc& acc, const GUnit& g, int wr, int wc, int fr, int fq) const {
        LAS unsigned char* bb = EPI_BB(lds); const int l = EPI_LANE;
#pragma unroll
        EPI_FOR_ROWS {
            const f32x4 r0 = silu4(acc[ai][0][m][0]) * acc[ai][1][m][0], r1 = silu4(acc[ai][0][m][1]) * acc[ai][1][m][1];
            *(u32x4*)(out + ((size_t)g.pm * 256 + ai * 128 + wr * 64 + m * 16 + (l >> 2)) * 256 + g.pn * 128 + wc * 32 + 8 * (l & 3)) = bb_out64(bb, fr, fq, pack8(r0, r1)); }
    } };
struct EpiShDown { bf16* H; LAS unsigned char* lds;
    __device__ __forceinline__ void operator()(const Acc& acc, const GUnit& g, int wr, int wc, int fr, int fq) const {
        LAS unsigned char* bb = EPI_BB(lds); const int l = EPI_LANE;
#pragma unroll
        for (int ai = 0; ai < 2; ++ai) {
            u32x4 hv[4][2];
#pragma unroll
            for (int m = 0; m < 4; ++m)
#pragma unroll
                for (int bj = 0; bj < 2; ++bj) hv[m][bj] = *(const u32x4*)(H + ((size_t)g.pm * 256 + ai * 128 + wr * 64 + m * 16 + (l >> 2)) * 1024 + g.pn * 256 + bj * 128 + wc * 32 + 8 * (l & 3));
#pragma unroll
            for (int m = 0; m < 4; ++m)
#pragma unroll
                for (int bj = 0; bj < 2; ++bj) { f32x4 h0, h1; unpack8(bb_in64(bb, fr, fq, hv[m][bj]), h0, h1);
                    *(u32x4*)(H + ((size_t)g.pm * 256 + ai * 128 + wr * 64 + m * 16 + (l >> 2)) * 1024 + g.pn * 256 + bj * 128 + wc * 32 + 8 * (l & 3)) = bb_out64(bb, fr, fq, pack8(h0 * DN_ALPHA + acc[ai][bj][m][0], h1 * DN_ALPHA + acc[ai][bj][m][1])); }
        }
    } };
__device__ __forceinline__ u32x4 pair16(const u32x2 wa, const u32x2 wb) {
    const auto sx = __builtin_amdgcn_permlane16_swap(wa.x, wb.x, false, false), sy = __builtin_amdgcn_permlane16_swap(wa.y, wb.y, false, false);
    return (u32x4){sx[0], sy[0], sx[1], sy[1]};
}
struct EpiSwiglu8 { unsigned char* out; LAS unsigned char* lds;
    __device__ __forceinline__ void operator()(const Acc& acc, const GUnit& g, int wr, int wc, int fr, int fq) const {
        constexpr float SC = (float)(1 << FP8_A_SHIFT);
#pragma unroll
        for (int ai = 0; ai < 2; ++ai)
#pragma unroll
            for (int mh = 0; mh < 2; ++mh) { u32x2 w[2];
#pragma unroll
                for (int m2 = 0; m2 < 2; ++m2) { const int m = 2 * mh + m2; const f32x4 r0 = silu4(acc[ai][0][m][0]) * acc[ai][1][m][0] * SC, r1 = silu4(acc[ai][0][m][1]) * acc[ai][1][m][1] * SC;
                    w[m2].x = pk4_fp8(r0[0], r0[1], r0[2], r0[3]); w[m2].y = pk4_fp8(r1[0], r1[1], r1[2], r1[3]); }
                *(u32x4*)(out + ((size_t)g.pm * 256 + ai * 128 + wr * 64 + (2 * mh + (fq & 1)) * 16 + fr) * 256 + g.pn * 128 + wc * 32 + (fq >> 1) * 16) = pair16(w[0], w[1]); }
    } };
struct EpiFp8Tile { unsigned char* out; LAS unsigned char* lds;
    __device__ __forceinline__ void operator()(const Acc& acc, const GUnit& g, int wr, int wc, int fr, int fq) const {
        constexpr float SC = (float)(1 << FP8_Y_SHIFT);
#pragma unroll
        EPI_FOR_ROWS { u32x2 w[2];
#pragma unroll
            for (int bj = 0; bj < 2; ++bj) { const f32x4 r0 = acc[ai][bj][m][0] * SC, r1 = acc[ai][bj][m][1] * SC; w[bj].x = pk4_fp8(r0[0], r0[1], r0[2], r0[3]); w[bj].y = pk4_fp8(r1[0], r1[1], r1[2], r1[3]); }
            *(u32x4*)(out + ((size_t)g.pm * 256 + ai * 128 + wr * 64 + m * 16 + fr) * 1024 + g.pn * 256 + (fq & 1) * 128 + wc * 32 + (fq >> 1) * 16) = pair16(w[0], w[1]); }
    } };

constexpr int GL_WUP = 0, GL_BG = 8192, GL_NG = 8704, GL_GD = 9728, GL_SS = 10240, GL_RS = 12288, GL_QD = 12800, GL_KI = GL_QD + 17408, GL_KET = GL_KI + 17408, GL_VT = GL_KET + 18432, GL_PM = GL_VT + 36864, GL_BT = GL_PM + 9216;
static_assert(GL_PM + 9216 <= 131072 && 64 * 264 * 2 <= 2 * 17408 && GL_BT + 8 * 64 * 20 * 4 <= MISC_OFF, "GLA LDS");
constexpr int QS = 136, TS = 72, VRS = 264;
typedef short v4i16_t __attribute__((ext_vector_type(4)));
static_assert(64 * VRS * 2 <= 36864, "GLA V image");

__device__ __forceinline__ void gla_unit(Frame& F, int b, int h) {
    PHASE_IDS(F);
    LAS unsigned char* L = F.lds;
    LAS float* WUP = (LAS float*)(L + GL_WUP); LAS float* BG = (LAS float*)(L + GL_BG); LAS float* NG = (LAS float*)(L + GL_NG);
    LAS float* GD = (LAS float*)(L + GL_GD); LAS float* SS = (LAS float*)(L + GL_SS); LAS float* RS = (LAS float*)(L + GL_RS);
    LAS bf16* QD = (LAS bf16*)(L + GL_QD); LAS bf16* KI = (LAS bf16*)(L + GL_KI); LAS bf16* KET = (LAS bf16*)(L + GL_KET); LAS bf16* VT = (LAS bf16*)(L + GL_VT); LAS bf16* PM = (LAS bf16*)(L + GL_PM);
    const int tid = F.tid, lane = F.lane, w = F.wave, fr = lane & 15, fq = lane >> 4;
    bf16* P = WSP(bf16, WS_P); const float* GLW = WSP(float, WS_GL);
    __syncthreads();
    float wB[4], LA[4];
#pragma unroll
    for (int s4 = 0; s4 < 4; ++s4) { wB[s4] = F.in[10][(4 * fq + s4) * 512 + h * 128 + 16 * w + fr]; LA[s4] = (s4 < (fr & 3) || (s4 == (fr & 3) && fq < (fr >> 2))) ? 1.0f : 0.0f; }
    const float biasv = F.in[11][h * 128 + 16 * w + fr];
    if (tid < 256) NG[tid] = F.in[12][h * 256 + tid];
    f32x4 S[8][2];
#pragma unroll
    for (int kt = 0; kt < 8; ++kt) { S[kt][0] = (f32x4){0.f, 0.f, 0.f, 0.f}; S[kt][1] = (f32x4){0.f, 0.f, 0.f, 0.f}; }
    __syncthreads();
    const int dv0 = 32 * w;
    f32x4 gvn[4];
#pragma unroll
    for (int mt = 0; mt < 4; ++mt) gvn[mt] = *(const f32x4*)(GLW + ((size_t)b * SEQ + 16 * mt + fr) * 16 + 4 * fq);
    for (int ch = 0; ch < 32; ++ch) {
        const size_t row0 = (size_t)b * SEQ + 64 * ch;
        const size_t pan = row0 >> 8; const int r0l = (int)(row0 & 255);
        const bf16* tq = P + ((pan * NPT + (C_Q >> 8) + (h >> 1)) << 16) + (h & 1) * 128; const bf16* tk = P + ((pan * NPT + (C_K >> 8) + (h >> 1)) << 16) + (h & 1) * 128;
        const bf16* tv = P + ((pan * NPT + (C_V >> 8) + h) << 16); bf16* tr = P + ((pan * NPT + (C_R >> 8) + h) << 16);
        { float la[16], blv[16];
          u32x4 qv[2], kv[2], vvv[4];
          { const bf16* qp = tq + (r0l + lane) * 256 + 16 * w; qv[0] = *(const u32x4*)qp; qv[1] = *(const u32x4*)(qp + 8); }
          { const bf16* kp = tk + (r0l + lane) * 256 + 16 * w; kv[0] = *(const u32x4*)kp; kv[1] = *(const u32x4*)(kp + 8); }
#pragma unroll
          for (int i = 0; i < 4; ++i) vvv[i] = *(const u32x4*)(tv + (r0l + lane) * 256 + dv0 + 8 * i);
          { f32x4 lg[4], gv[4];
#define MFMA_F32X4(acc_, a_, b_) asm volatile("s_nop 1\n\tv_mfma_f32_16x16x4_f32 %0, %1, %2, %0" : "+v"(acc_) : "v"(a_), "v"(b_))
#define MFMA_F32X4_LAST(acc_, a_, b_) asm volatile("s_nop 1\n\tv_mfma_f32_16x16x4_f32 %0, %1, %2, %0\n\ts_nop 15" : "+v"(acc_) : "v"(a_), "v"(b_))
#define MFMA_F32X4_DEP_LAST(acc_, a_, b_) asm volatile("s_nop 9\n\tv_mfma_f32_16x16x4_f32 %0, %1, %2, %0\n\ts_nop 15" : "+v"(acc_) : "v"(a_), "v"(b_))
#define MFMA_F32X4_DEP(acc_, a_, b_) asm volatile("s_nop 9\n\tv_mfma_f32_16x16x4_f32 %0, %1, %2, %0" : "+v"(acc_) : "v"(a_), "v"(b_))
#pragma unroll
            for (int mt = 0; mt < 4; ++mt) { gv[mt] = gvn[mt]; lg[mt] = (f32x4){biasv, biasv, biasv, biasv}; }
#pragma unroll
            for (int s4 = 0; s4 < 4; ++s4)
#pragma unroll
                for (int mt = 0; mt < 4; ++mt) if (s4 < 3) MFMA_F32X4(lg[mt], gv[mt][s4], wB[s4]);
            asm volatile("s_nop 1\n\tv_mfma_f32_16x16x4_f32 %0, %4, %8, %0\n\tv_mfma_f32_16x16x4_f32 %1, %5, %8, %1\n\tv_mfma_f32_16x16x4_f32 %2, %6, %8, %2\n\tv_mfma_f32_16x16x4_f32 %3, %7, %8, %3\n\ts_nop 15"
                         : "+v"(lg[0]), "+v"(lg[1]), "+v"(lg[2]), "+v"(lg[3]) : "v"(gv[0][3]), "v"(gv[1][3]), "v"(gv[2][3]), "v"(gv[3][3]), "v"(wB[3]));
            if (ch + 1 < 32) {
#pragma unroll
                for (int mt = 0; mt < 4; ++mt) gvn[mt] = *(const f32x4*)(GLW + (row0 + 64 + 16 * mt + fr) * 16 + 4 * fq); }
#pragma unroll
            for (int mt = 0; mt < 4; ++mt) {
#pragma unroll
                for (int r = 0; r < 4; ++r) { const float x = lg[mt][r]; lg[mt][r] = (fminf(x, 0.f) - __builtin_amdgcn_logf(1.0f + __expf(-fabsf(x))) * 0.6931471805599453f) * (1.0f / 16.0f); }
                lg[mt][1] += lg[mt][0]; lg[mt][2] += lg[mt][1]; lg[mt][3] += lg[mt][2]; }
            f32x4 ex = (f32x4){0.f, 0.f, 0.f, 0.f};
#pragma unroll
            for (int kt = 0; kt < 4; ++kt) { if (kt < 3) MFMA_F32X4_DEP(ex, LA[kt], lg[kt][3]); else MFMA_F32X4_DEP_LAST(ex, LA[kt], lg[kt][3]); }
#undef MFMA_F32X4
#undef MFMA_F32X4_DEP
#undef MFMA_F32X4_LAST
#undef MFMA_F32X4_DEP_LAST
            LAS float* BT = (LAS float*)(L + GL_BT) + w * (64 * 20);
#pragma unroll
            for (int mt = 0; mt < 4; ++mt)
#pragma unroll
                for (int r = 0; r < 4; ++r) BT[(16 * mt + 4 * fq + r) * 20 + fr] = lg[mt][r] + ex[mt];
            if (fq == 3) GD[16 * w + fr] = __expf(lg[3][3] + ex[3]);
#pragma unroll
            for (int i = 0; i < 4; ++i) { const f32x4 t = *(const LAS f32x4*)(BT + lane * 20 + 4 * i), u = *(const LAS f32x4*)(GD + 16 * w + 4 * i);
                la[4 * i] = t[0]; la[4 * i + 1] = t[1]; la[4 * i + 2] = t[2]; la[4 * i + 3] = t[3]; blv[4 * i] = u[0]; blv[4 * i + 1] = u[1]; blv[4 * i + 2] = u[2]; blv[4 * i + 3] = u[3]; } }
          unsigned qo[8], ko[8];
#pragma unroll
          for (int j2 = 0; j2 < 8; ++j2) {
              const unsigned qw = qv[j2 >> 2][j2 & 3], kw = kv[j2 >> 2][j2 & 3];
              const float b0 = la[2 * j2], b1 = la[2 * j2 + 1];
              const float bl0 = blv[2 * j2], bl1 = blv[2 * j2 + 1];
              const float e0 = __builtin_amdgcn_exp2f(fmaf(b0, 1.4426950408889634f, -3.5f)), e1 = __builtin_amdgcn_exp2f(fmaf(b1, 1.4426950408889634f, -3.5f)), i0 = __builtin_amdgcn_exp2f(b0 * -1.4426950408889634f), i1 = __builtin_amdgcn_exp2f(b1 * -1.4426950408889634f);
              qo[j2] = pk2(lo16(qw) * e0, hi16(qw) * e1);
              const float ki0 = lo16(kw) * i0, ki1 = hi16(kw) * i1;
              ko[j2] = pk2(ki0, ki1);
              const float g0 = bl0, g1 = bl1; const float ke0 = ki0 * g0, ke1 = ki1 * g1;
              KET[(16 * w + 2 * j2) * TS + lane] = (bf16)f2bf(ke0); KET[(16 * w + 2 * j2 + 1) * TS + lane] = (bf16)f2bf(ke1);
          }
          *(LAS u32x4*)(QD + lane * QS + 16 * w) = (u32x4){qo[0], qo[1], qo[2], qo[3]}; *(LAS u32x4*)(QD + lane * QS + 16 * w + 8) = (u32x4){qo[4], qo[5], qo[6], qo[7]};
          *(LAS u32x4*)(KI + lane * QS + 16 * w) = (u32x4){ko[0], ko[1], ko[2], ko[3]}; *(LAS u32x4*)(KI + lane * QS + 16 * w + 8) = (u32x4){ko[4], ko[5], ko[6], ko[7]};
#pragma unroll
          for (int i = 0; i < 4; ++i) *(LAS u32x4*)(VT + lane * VRS + dv0 + 8 * i) = vvv[i];
        }
        __syncthreads();
#pragma unroll
        for (int tt = 0; tt < 2; ++tt) { const int tl = 2 * w + tt, it = tl >> 2, jt = tl & 3;
            f32x4 acc = (f32x4){0.f, 0.f, 0.f, 0.f};
            if (jt <= it) {
#pragma unroll
                for (int ks = 0; ks < 4; ++ks) { const bf16x8 a = *(const LAS bf16x8*)(QD + (16 * it + fr) * QS + 32 * ks + 8 * fq); const bf16x8 bb = *(const LAS bf16x8*)(KI + (16 * jt + fr) * QS + 32 * ks + 8 * fq);
                    acc = __builtin_amdgcn_mfma_f32_16x16x32_bf16(a, bb, acc, 0, 0, 0); } }
#pragma unroll
            for (int r = 0; r < 4; ++r) { const int i = 16 * it + 4 * fq + r, j = 16 * jt + fr; PM[i * TS + j] = (j <= i) ? (bf16)f2bf(acc[r]) : (bf16)0; } }
        __syncthreads();
        u32x4 rpre[4];
#pragma unroll
        for (int i = 0; i < 4; ++i) { const int idx = tid + 512 * i, tok = idx >> 5, c = (idx & 31) * 8; rpre[i] = *(const u32x4*)(tr + (r0l + tok) * 256 + c); }
        bf16x8 vb[2][2];
#pragma unroll
        for (int ks = 0; ks < 2; ++ks)
#pragma unroll
            for (int nt = 0; nt < 2; ++nt) {
                const LAS bf16* vp = VT + (32 * ks + 8 * fq + (fr >> 2)) * VRS + dv0 + 16 * nt + 4 * (fr & 3);
                const v4i16_t lo = __builtin_amdgcn_ds_read_tr16_b64_v4i16((LAS v4i16_t*)vp), hi = __builtin_amdgcn_ds_read_tr16_b64_v4i16((LAS v4i16_t*)(vp + 4 * VRS));
                vb[ks][nt] = __builtin_shufflevector(lo, hi, 0, 1, 2, 3, 4, 5, 6, 7); }
        f32x4 o[4][2];
#pragma unroll
        for (int mt = 0; mt < 4; ++mt) { o[mt][0] = (f32x4){0.f, 0.f, 0.f, 0.f}; o[mt][1] = (f32x4){0.f, 0.f, 0.f, 0.f}; }
#pragma unroll
        for (int k4 = 0; k4 < 4; ++k4) {
            bf16x8 sb[2];
#pragma unroll
            for (int nt = 0; nt < 2; ++nt) { const f32x4 s0 = S[2 * k4][nt], s1 = S[2 * k4 + 1][nt]; u32x4 pw; pw.x = pk2(s0[0], s0[1]); pw.y = pk2(s0[2], s0[3]); pw.z = pk2(s1[0], s1[1]); pw.w = pk2(s1[2], s1[3]); sb[nt] = __builtin_bit_cast(bf16x8, pw); }
#pragma unroll
            for (int mt = 0; mt < 4; ++mt) { const u32x2 q0 = *(const LAS u32x2*)(QD + (16 * mt + fr) * QS + 32 * k4 + 4 * fq); const u32x2 q1 = *(const LAS u32x2*)(QD + (16 * mt + fr) * QS + 32 * k4 + 16 + 4 * fq);
                const bf16x8 aq = __builtin_bit_cast(bf16x8, (u32x4){q0.x, q0.y, q1.x, q1.y});
                o[mt][0] = __builtin_amdgcn_mfma_f32_16x16x32_bf16(aq, sb[0], o[mt][0], 0, 0, 0); o[mt][1] = __builtin_amdgcn_mfma_f32_16x16x32_bf16(aq, sb[1], o[mt][1], 0, 0, 0); } }
#pragma unroll
        for (int mt = 0; mt < 4; ++mt)
#pragma unroll
            for (int ks = 0; ks < 2; ++ks) if (ks <= (mt >> 1)) { const bf16x8 ap = *(const LAS bf16x8*)(PM + (16 * mt + fr) * TS + 32 * ks + 8 * fq);
                o[mt][0] = __builtin_amdgcn_mfma_f32_16x16x32_bf16(ap, vb[ks][0], o[mt][0], 0, 0, 0); o[mt][1] = __builtin_amdgcn_mfma_f32_16x16x32_bf16(ap, vb[ks][1], o[mt][1], 0, 0, 0); }
#pragma unroll
        for (int kt = 0; kt < 8; ++kt) { const f32x4 gd = *(const LAS f32x4*)(GD + 16 * kt + 4 * fq);
            S[kt][0] = S[kt][0] * gd; S[kt][1] = S[kt][1] * gd;
#pragma unroll
            for (int ks = 0; ks < 2; ++ks) { const bf16x8 ak = *(const LAS bf16x8*)(KET + (16 * kt + fr) * TS + 32 * ks + 8 * fq);
                S[kt][0] = __builtin_amdgcn_mfma_f32_16x16x32_bf16(ak, vb[ks][0], S[kt][0], 0, 0, 0); S[kt][1] = __builtin_amdgcn_mfma_f32_16x16x32_bf16(ak, vb[ks][1], S[kt][1], 0, 0, 0); } }
        { float ss[16];
#pragma unroll
          for (int mt = 0; mt < 4; ++mt)
#pragma unroll
              for (int r = 0; r < 4; ++r) ss[4 * mt + r] = o[mt][0][r] * o[mt][0][r] + o[mt][1][r] * o[mt][1][r];
#define GLA_RED8(D, o_) asm volatile("s_nop 1\n\tv_add_f32_dpp %0, %0, %0 row_shr:" #D " row_mask:0xf bank_mask:0xf\n\tv_add_f32_dpp %1, %1, %1 row_shr:" #D " row_mask:0xf bank_mask:0xf\n\tv_add_f32_dpp %2, %2, %2 row_shr:" #D " row_mask:0xf bank_mask:0xf\n\tv_add_f32_dpp %3, %3, %3 row_shr:" #D " row_mask:0xf bank_mask:0xf\n\t" \
              "v_add_f32_dpp %4, %4, %4 row_shr:" #D " row_mask:0xf bank_mask:0xf\n\tv_add_f32_dpp %5, %5, %5 row_shr:" #D " row_mask:0xf bank_mask:0xf\n\tv_add_f32_dpp %6, %6, %6 row_shr:" #D " row_mask:0xf bank_mask:0xf\n\tv_add_f32_dpp %7, %7, %7 row_shr:" #D " row_mask:0xf bank_mask:0xf" \
              : "+v"(ss[o_]), "+v"(ss[o_ + 1]), "+v"(ss[o_ + 2]), "+v"(ss[o_ + 3]), "+v"(ss[o_ + 4]), "+v"(ss[o_ + 5]), "+v"(ss[o_ + 6]), "+v"(ss[o_ + 7]))
          GLA_RED8(1, 0); GLA_RED8(1, 8); GLA_RED8(2, 0); GLA_RED8(2, 8); GLA_RED8(4, 0); GLA_RED8(4, 8); GLA_RED8(8, 0); GLA_RED8(8, 8);
#undef GLA_RED8
          if (fr == 15) {
#pragma unroll
              for (int mt = 0; mt < 4; ++mt) *(LAS f32x4*)(SS + w * 64 + 16 * mt + 4 * fq) = (f32x4){ss[4 * mt], ss[4 * mt + 1], ss[4 * mt + 2], ss[4 * mt + 3]}; } }
        __syncthreads();
        { LAS bf16* OT = (LAS bf16*)(L + GL_QD);
#pragma unroll
          for (int mt = 0; mt < 4; ++mt)
#pragma unroll
              for (int r = 0; r < 4; ++r) { const int tok = 16 * mt + 4 * fq + r;
#pragma unroll
                  for (int nt = 0; nt < 2; ++nt) { const int dv = dv0 + 16 * nt + fr; OT[tok * 264 + dv] = (bf16)f2bf(o[mt][nt][r] * NG[dv]); } }
          __syncthreads();
#pragma unroll
          for (int i = 0; i < 4; ++i) { const int idx = tid + 512 * i, tok = idx >> 5, c = (idx & 31) * 8;
              const u32x4 ov = *(const LAS u32x4*)(OT + tok * 264 + c); const int po = (r0l + tok) * 256 + c; const u32x4 rv = rpre[i]; u32x4 w;
              float t = 0.f;
#pragma unroll
              for (int ww = 0; ww < 8; ++ww) t += SS[ww * 64 + tok];
              const float rs = __builtin_amdgcn_rsqf(t * (1.0f / 256.0f) + RMS_EPS);
              constexpr float SC = (float)(1 << FP8_A_SHIFT); float f[8];
              const float rsc = rs * SC;
#pragma unroll
              for (int j = 0; j < 4; ++j) { f[2 * j] = (lo16(ov[j]) * lo16(rv[j])) * rsc; f[2 * j + 1] = (hi16(ov[j]) * hi16(rv[j])) * rsc; }
              u32x2 o8; o8.x = pk4_fp8(f[0], f[1], f[2], f[3]); o8.y = pk4_fp8(f[4], f[5], f[6], f[7]); (void)w; (void)po;
              *(u32x2*)((unsigned char*)F.out + pan * H8_PANEL + 262144 + (size_t)(r0l + tok) * 1024 + h * 256 + c) = o8; }
          __syncthreads(); }
    }
}

constexpr int LR_CW = 0, LR_CB = 1024, LR_BA = 1280, LR_BX = 1536, LR_SP = 1792, LR_HC = 2048, LR_AGG = 2304, LR_HIN = 6400, LR_W = 8448, LR_XA = 24832, LR_GA = LR_XA + 259 * 144 + 16  , LR_RS = 144;
static_assert(LR_XA % 16 == 0 && LR_GA % 16 == 0 && LR_GA + 256 * 144 <= 131072, "LRU LDS");

__device__ __forceinline__ void lru_unit(Frame& F, int b, int g) {
    F.lane = F.tid & 63; F.wave = __builtin_amdgcn_readfirstlane(F.tid >> 6);
    LAS unsigned char* L = F.lds;
    LAS float* CW = (LAS float*)(L + LR_CW); LAS float* CB = (LAS float*)(L + LR_CB); LAS float* BA = (LAS float*)(L + LR_BA); LAS float* BX = (LAS float*)(L + LR_BX);
    LAS float* SP = (LAS float*)(L + LR_SP); LAS float* HC = (LAS float*)(L + LR_HC); LAS float* AGG = (LAS float*)(L + LR_AGG); LAS float* HIN = (LAS float*)(L + LR_HIN); LAS bf16* WL = (LAS bf16*)(L + LR_W);
    const int tid = F.tid, lane = F.lane, w = F.wave, fr = lane & 15, fq = lane >> 4;
    bf16* P = WSP(bf16, WS_P);
    __syncthreads();
    if (tid < 256) CW[tid] = F.in[2][(tid >> 6) * 1024 + 64 * g + (tid & 63)];
    if (tid < 64) { const int c = 64 * g + tid; CB[tid] = F.in[3][c]; BA[tid] = F.in[5][c]; BX[tid] = F.in[7][c]; const float lam = F.in[8][c];
        SP[tid] = -1.4426950408889634f * 8.0f * (fmaxf(-lam, 0.f) + log1pf(__expf(-fabsf(lam)))); HC[tid] = 0.f; }
    { const u32x4* src = (const u32x4*)(WSP(bf16, WS_LRUW) + (size_t)g * 2 * 4096); LAS u32x4* dst = (LAS u32x4*)WL; dst[tid] = src[tid]; dst[tid + 512] = src[tid + 512]; }
    __syncthreads();
    LAS unsigned char* XA = L + LR_XA; LAS unsigned char* GA = L + LR_GA;
    u32x4 pfx[5], pfg[4];
#define LRU_PREFETCH(stn) do { int tz_ = tid; asm volatile("" : "+v"(tz_)); const int t0_ = (stn) * 256; const size_t pn_ = ((size_t)b * SEQ + t0_) >> 8; \
        const bf16* txa_ = P + ((pn_ * NPT + (C_XA >> 8) + (g >> 2)) << 16) + (g & 3) * 64; const bf16* tga_ = P + ((pn_ * NPT + (C_GA >> 8) + (g >> 2)) << 16) + (g & 3) * 64; \
        _Pragma("unroll") for (int i = 0; i < 5; ++i) { const int p = tz_ + 512 * i; pfx[i] = (u32x4){0u, 0u, 0u, 0u}; if (p < 259 * 8) { const int r = p >> 3, c16 = p & 7, t = t0_ - 3 + r; \
            if (t >= 0) pfx[i] = *(const u32x4*)(txa_ + (r >= 3 ? (r - 3) * 256 : (r - 3 + 256) * 256 - (NPT << 16)) + 8 * c16); } } \
        _Pragma("unroll") for (int i = 0; i < 4; ++i) { const int p = tz_ + 512 * i, r = p >> 3, c16 = p & 7; pfg[i] = *(const u32x4*)(tga_ + r * 256 + 8 * c16); } } while (0)
    LRU_PREFETCH(0);
    for (int st = 0; st < 8; ++st) {
        const int tb = st * 256 + w * 32, t0 = st * 256;
        __syncthreads();
        int tz = tid; asm volatile("" : "+v"(tz));
        const size_t panl = ((size_t)b * SEQ + t0) >> 8;
        bf16* tga = P + ((panl * NPT + (C_GA >> 8) + (g >> 2)) << 16) + (g & 3) * 64;
#pragma unroll
        for (int i = 0; i < 5; ++i) { const int p = tz + 512 * i; if (p < 259 * 8) { const int r = p >> 3, c16 = p & 7; *(LAS u32x4*)(XA + r * LR_RS + c16 * 16) = pfx[i]; } }
#pragma unroll
        for (int i = 0; i < 4; ++i) { const int p = tz + 512 * i, r = p >> 3, c16 = p & 7; *(LAS u32x4*)(GA + r * LR_RS + c16 * 16) = pfg[i]; }
        __syncthreads();
        if (st + 1 < 8) LRU_PREFETCH(st + 1);
        float Aa[2][16], Uu[2][16];
#pragma unroll
        for (int mt = 0; mt < 2; ++mt) {
            float xc[2][8];
#pragma unroll
            for (int ks = 0; ks < 2; ++ks) {
                const int c0 = 32 * ks + 8 * fq;
                { const f32x4 b0 = *(const LAS f32x4*)(CB + c0), b1 = *(const LAS f32x4*)(CB + c0 + 4);
                  xc[ks][0] = b0[0]; xc[ks][1] = b0[1]; xc[ks][2] = b0[2]; xc[ks][3] = b0[3]; xc[ks][4] = b1[0]; xc[ks][5] = b1[1]; xc[ks][6] = b1[2]; xc[ks][7] = b1[3]; }
#pragma unroll
                for (int tap = 0; tap < 4; ++tap) {
                    const u32x4 xv = *(const LAS u32x4*)(XA + (w * 32 + 16 * mt + fr + tap) * LR_RS + c0 * 2);
                    const f32x4 w0 = *(const LAS f32x4*)(CW + tap * 64 + c0), w1 = *(const LAS f32x4*)(CW + tap * 64 + c0 + 4);
                    xc[ks][0] += w0[0] * lo16(xv.x); xc[ks][1] += w0[1] * hi16(xv.x); xc[ks][2] += w0[2] * lo16(xv.y); xc[ks][3] += w0[3] * hi16(xv.y);
                    xc[ks][4] += w1[0] * lo16(xv.z); xc[ks][5] += w1[1] * hi16(xv.z); xc[ks][6] += w1[2] * lo16(xv.w); xc[ks][7] += w1[3] * hi16(xv.w);
                }
            }
            bf16x8 xf[2];
#pragma unroll
            for (int ks = 0; ks < 2; ++ks) { u32x4 pw; pw.x = pk2(xc[ks][0], xc[ks][1]); pw.y = pk2(xc[ks][2], xc[ks][3]); pw.z = pk2(xc[ks][4], xc[ks][5]); pw.w = pk2(xc[ks][6], xc[ks][7]); xf[ks] = __builtin_bit_cast(bf16x8, pw); }
#pragma unroll
            for (int nt = 0; nt < 4; ++nt) {
                const int nact = 32 * (nt >> 1) + 8 * (fr >> 2) + 4 * (nt & 1) + (fr & 3);
                f32x4 ar = (f32x4){0.f, 0.f, 0.f, 0.f}, ax = (f32x4){0.f, 0.f, 0.f, 0.f};
#pragma unroll
                for (int ks = 0; ks < 2; ++ks) { const bf16x8 wa = *(const LAS bf16x8*)(WL + nact * 64 + 32 * ks + 8 * fq); const bf16x8 wx = *(const LAS bf16x8*)(WL + 4096 + nact * 64 + 32 * ks + 8 * fq);
                    ar = __builtin_amdgcn_mfma_f32_16x16x32_bf16(wa, xf[ks], ar, 0, 0, 0); ax = __builtin_amdgcn_mfma_f32_16x16x32_bf16(wx, xf[ks], ax, 0, 0, 0); }
                const int cb = 32 * (nt >> 1) + 8 * fq + 4 * (nt & 1);
                const f32x4 ba = *(const LAS f32x4*)(BA + cb), bx = *(const LAS f32x4*)(BX + cb), sp = *(const LAS f32x4*)(SP + cb);
#pragma unroll
                for (int r = 0; r < 4; ++r) {
                    const float rg = sigmoidf_(ar[r] + ba[r]), ig = sigmoidf_(ax[r] + bx[r]);
                    const float a = __builtin_amdgcn_exp2f(rg * sp[r]);
                    Aa[mt][4 * nt + r] = a; Uu[mt][4 * nt + r] = __builtin_amdgcn_sqrtf(fmaf(-a, a, 1.0f)) * ig * xc[nt >> 1][4 * (nt & 1) + r];
                }
            }
#define LRU_U8(D, o) asm volatile("s_nop 1\n\tv_fmac_f32_dpp %0, %0, %8 row_shr:" #D " row_mask:0xf bank_mask:0xf\n\tv_fmac_f32_dpp %1, %1, %9 row_shr:" #D " row_mask:0xf bank_mask:0xf\n\tv_fmac_f32_dpp %2, %2, %10 row_shr:" #D " row_mask:0xf bank_mask:0xf\n\tv_fmac_f32_dpp %3, %3, %11 row_shr:" #D " row_mask:0xf bank_mask:0xf\n\t" \
                "v_fmac_f32_dpp %4, %4, %12 row_shr:" #D " row_mask:0xf bank_mask:0xf\n\tv_fmac_f32_dpp %5, %5, %13 row_shr:" #D " row_mask:0xf bank_mask:0xf\n\tv_fmac_f32_dpp %6, %6, %14 row_shr:" #D " row_mask:0xf bank_mask:0xf\n\tv_fmac_f32_dpp %7, %7, %15 row_shr:" #D " row_mask:0xf bank_mask:0xf" \
                : "+v"(Uu[mt][o]), "+v"(Uu[mt][o + 1]), "+v"(Uu[mt][o + 2]), "+v"(Uu[mt][o + 3]), "+v"(Uu[mt][o + 4]), "+v"(Uu[mt][o + 5]), "+v"(Uu[mt][o + 6]), "+v"(Uu[mt][o + 7]) \
                : "v"(Aa[mt][o]), "v"(Aa[mt][o + 1]), "v"(Aa[mt][o + 2]), "v"(Aa[mt][o + 3]), "v"(Aa[mt][o + 4]), "v"(Aa[mt][o + 5]), "v"(Aa[mt][o + 6]), "v"(Aa[mt][o + 7]))
#define LRU_A8(D, o) asm volatile("s_nop 1\n\tv_mul_f32_dpp %0, %0, %0 row_shr:" #D " row_mask:0xf bank_mask:0xf\n\tv_mul_f32_dpp %1, %1, %1 row_shr:" #D " row_mask:0xf bank_mask:0xf\n\tv_mul_f32_dpp %2, %2, %2 row_shr:" #D " row_mask:0xf bank_mask:0xf\n\tv_mul_f32_dpp %3, %3, %3 row_shr:" #D " row_mask:0xf bank_mask:0xf\n\t" \
                "v_mul_f32_dpp %4, %4, %4 row_shr:" #D " row_mask:0xf bank_mask:0xf\n\tv_mul_f32_dpp %5, %5, %5 row_shr:" #D " row_mask:0xf bank_mask:0xf\n\tv_mul_f32_dpp %6, %6, %6 row_shr:" #D " row_mask:0xf bank_mask:0xf\n\tv_mul_f32_dpp %7, %7, %7 row_shr:" #D " row_mask:0xf bank_mask:0xf" \
                : "+v"(Aa[mt][o]), "+v"(Aa[mt][o + 1]), "+v"(Aa[mt][o + 2]), "+v"(Aa[mt][o + 3]), "+v"(Aa[mt][o + 4]), "+v"(Aa[mt][o + 5]), "+v"(Aa[mt][o + 6]), "+v"(Aa[mt][o + 7]))
#define LRU_STEP(D) do { LRU_U8(D, 0); LRU_U8(D, 8); LRU_A8(D, 0); LRU_A8(D, 8); } while (0)
            LRU_STEP(1); LRU_STEP(2); LRU_STEP(4); LRU_STEP(8);
#undef LRU_U8
#undef LRU_A8
#undef LRU_STEP
            asm volatile("s_nop 1" ::: "memory");
            asm volatile("" ::: "memory");
        }
#pragma unroll
        for (int e = 0; e < 16; ++e) { const float a0 = lane_read(Aa[0][e], lane | 15), u0 = lane_read(Uu[0][e], lane | 15);
            Uu[1][e] = Aa[1][e] * u0 + Uu[1][e]; Aa[1][e] = Aa[1][e] * a0; }
        if (fr == 15) {
#pragma unroll
            for (int e = 0; e < 16; ++e) { const int c = 32 * (e >> 3) + 8 * fq + (e & 7); *(LAS f32x2_t*)(AGG + (w * 64 + c) * 2) = (f32x2_t){Aa[1][e], Uu[1][e]}; } }
        __syncthreads();
        if (w == 0) { float hc = HC[lane];
#pragma unroll
            for (int ww = 0; ww < 8; ++ww) { HIN[ww * 64 + lane] = hc; hc = AGG[(ww * 64 + lane) * 2] * hc + AGG[(ww * 64 + lane) * 2 + 1]; }
            HC[lane] = hc; }
        __syncthreads();
        float hin[16];
#pragma unroll
        for (int e = 0; e < 16; ++e) hin[e] = HIN[w * 64 + 32 * (e >> 3) + 8 * fq + (e & 7)];
#pragma unroll
        for (int mt = 0; mt < 2; ++mt) {
            LAS unsigned char* grow = GA + (w * 32 + 16 * mt + fr) * LR_RS;
            u32x4 gv[2];
#pragma unroll
            for (int ks = 0; ks < 2; ++ks) gv[ks] = *(const LAS u32x4*)(grow + (32 * ks + 8 * fq) * 2);
#pragma unroll
            for (int ks = 0; ks < 2; ++ks) { float hv[8];
#pragma unroll
                for (int j2 = 0; j2 < 4; ++j2) { const int e0 = 8 * ks + 2 * j2;
                    const float h0 = Uu[mt][e0] + Aa[mt][e0] * hin[e0], h1 = Uu[mt][e0 + 1] + Aa[mt][e0 + 1] * hin[e0 + 1];
                    hv[2 * j2] = h0 * lo16(gv[ks][j2]) * (float)(1 << FP8_A_SHIFT); hv[2 * j2 + 1] = h1 * hi16(gv[ks][j2]) * (float)(1 << FP8_A_SHIFT); }
                u32x2 o8; o8.x = pk4_fp8(hv[0], hv[1], hv[2], hv[3]); o8.y = pk4_fp8(hv[4], hv[5], hv[6], hv[7]);
                *(LAS u32x2*)(grow + 32 * ks + 8 * fq) = o8; }
        }
        __syncthreads();
        asm volatile("" : "+v"(tz));
        { unsigned char* d8 = (unsigned char*)F.out + panl * H8_PANEL + 64 * g;
#pragma unroll
          for (int i = 0; i < 2; ++i) { const int p = tz + 512 * i, r = p >> 2, c = p & 3; *(u32x4*)(d8 + (size_t)r * 1024 + 16 * c) = *(const LAS u32x4*)(GA + r * LR_RS + 16 * c); } }
    }
}

#undef LRU_PREFETCH
__device__ __forceinline__ void phase_mixers(Frame& F, volatile LAS unsigned* MISC) {
    unsigned* head = (unsigned*)(F.ws + WS_CTL) + CW_MIXQ;
    for (;;) {
        __syncthreads();
        if (F.tid == 0) MISC[16] = __hip_atomic_fetch_add(head, 1u, __ATOMIC_RELAXED, __HIP_MEMORY_SCOPE_AGENT);
        __syncthreads();
        const int u = (int)MISC[16];
        if (u >= 128 + 512) break;
        if (u < 128) gla_unit(F, u >> 2, u & 3); else lru_unit(F, (u - 128) >> 4, (u - 128) & 15);
    }
}

__device__ __forceinline__ float wave_sum(float v) {
#pragma unroll
    for (int o = 1; o < 64; o <<= 1) v += __shfl_xor(v, o);
    return v;
}
__device__ __forceinline__ void ln_row(f32x4 (&v)[4]) {
    float s = 0.f;
#pragma unroll
    for (int j = 0; j < 4; ++j) s += (v[j][0] + v[j][1]) + (v[j][2] + v[j][3]);
    const float mean = wave_sum(s) * (1.f / 1024.f); float s2 = 0.f;
#pragma unroll
    for (int j = 0; j < 4; ++j) { v[j] = v[j] - mean; s2 += (v[j][0] * v[j][0] + v[j][1] * v[j][1]) + (v[j][2] * v[j][2] + v[j][3] * v[j][3]); }
    const float rstd = rsqrtf(wave_sum(s2) * (1.f / 1024.f) + LN_EPS);
#pragma unroll
    for (int j = 0; j < 4; ++j) v[j] = v[j] * rstd;
}
__device__ __forceinline__ void ln1_rows(Frame& F, int row_lo, int nrows) {
    PHASE_IDS(F);
    bf16* H = WSP(bf16, WS_H); unsigned char* H8P = (unsigned char*)F.out; constexpr float SC8 = (float)(1 << FP8_A_SHIFT);
    f32x4 gg[4], bb[4];
#pragma unroll
    for (int j = 0; j < 4; ++j) { gg[j] = *(const f32x4*)(F.in[15] + 8 * F.lane + 512 * (j >> 1) + 4 * (j & 1)); bb[j] = *(const f32x4*)(F.in[16] + 8 * F.lane + 512 * (j >> 1) + 4 * (j & 1)); }
    for (int r0 = row_lo + F.wave * 8; r0 < row_lo + nrows; r0 += 64) { u32x4 raw[8][2];
#pragma unroll
        for (int i = 0; i < 8; ++i)
#pragma unroll
            for (int j2 = 0; j2 < 2; ++j2) raw[i][j2] = *(const u32x4*)(H + (size_t)(r0 + i) * 1024 + 8 * F.lane + 512 * j2);
#pragma unroll
        for (int i = 0; i < 8; ++i) { f32x4 v[4]; unpack8(raw[i][0], v[0], v[1]); unpack8(raw[i][1], v[2], v[3]);
            ln_row(v);
#pragma unroll
            for (int j2 = 0; j2 < 2; ++j2) { const f32x4 o0 = v[2 * j2] * gg[2 * j2] + bb[2 * j2], o1 = v[2 * j2 + 1] * gg[2 * j2 + 1] + bb[2 * j2 + 1];
                *(u32x4*)(H + (size_t)(r0 + i) * 1024 + 8 * F.lane + 512 * j2) = pack8(o0, o1);
                u32x2 q; q.x = pk4_fp8(o0[0] * SC8, o0[1] * SC8, o0[2] * SC8, o0[3] * SC8); q.y = pk4_fp8(o1[0] * SC8, o1[1] * SC8, o1[2] * SC8, o1[3] * SC8);
                *(u32x2*)(H8P + (size_t)((r0 + i) >> 8) * H8_PANEL + ((r0 + i) & 255) * 1024 + 8 * F.lane + 512 * j2) = q; } } }
}
__device__ __forceinline__ void phase_combine(Frame& F) {
    PHASE_IDS(F);
    constexpr int NT = 2;
    const int gw = blockIdx.x * 8 + F.wave, NGW = gridDim.x * 8; const unsigned char* Y = WSP(unsigned char, WS_Y8); const int* ts = WSP(int, WS_TSLOT); const float* wt = WSP(float, WS_WT); const bf16* HR = WSP(bf16, WS_H);
    f32x4 gg[4], bb[4];
#pragma unroll
    for (int j = 0; j < 4; ++j) { gg[j] = *(const f32x4*)(F.in[25] + 16 * F.lane + 4 * j); bb[j] = *(const f32x4*)(F.in[26] + 16 * F.lane + 4 * j); }
    u32x4 s0n[NT], s1n[NT]; f32x4 w0n[NT], w1n[NT];
#pragma unroll
    for (int i = 0; i < NT; ++i) { const size_t t = (size_t)(gw * NT + i); s0n[i] = *(const u32x4*)(ts + t * 8); s1n[i] = *(const u32x4*)(ts + t * 8 + 4); w0n[i] = *(const f32x4*)(wt + t * 8); w1n[i] = *(const f32x4*)(wt + t * 8 + 4); }
    for (int t0 = gw * NT; t0 < T; t0 += NGW * NT) {
        u32x4 s0[NT], s1[NT]; f32x4 w0[NT], w1[NT];
#pragma unroll
        for (int i = 0; i < NT; ++i) { s0[i] = s0n[i]; s1[i] = s1n[i]; w0[i] = w0n[i]; w1[i] = w1n[i]; }
        if (t0 + NGW * NT < T) {
#pragma unroll
            for (int i = 0; i < NT; ++i) { const size_t t = (size_t)(t0 + NGW * NT + i); s0n[i] = *(const u32x4*)(ts + t * 8); s1n[i] = *(const u32x4*)(ts + t * 8 + 4); w0n[i] = *(const f32x4*)(wt + t * 8); w1n[i] = *(const f32x4*)(wt + t * 8 + 4); } }
        u32x4 y[NT][8];
#pragma unroll
        for (int i = 0; i < NT; ++i) {
#pragma unroll
            for (int k = 0; k < 8; ++k) { const unsigned sl = k < 4 ? s0[i][k & 3] : s1[i][k & 3]; y[i][k] = *(const u32x4*)(Y + (size_t)sl * 1024 + 16 * F.lane); } }
        f32x4 v[NT][4];
#pragma unroll
        for (int i = 0; i < NT; ++i) { const u32x4 r0 = *(const u32x4*)(HR + (size_t)(t0 + i) * 1024 + 16 * F.lane), r1 = *(const u32x4*)(HR + (size_t)(t0 + i) * 1024 + 16 * F.lane + 8);
            unpack8(r0, v[i][0], v[i][1]); unpack8(r1, v[i][2], v[i][3]); }
#pragma unroll
        for (int i = 0; i < NT; ++i) {
#pragma unroll
            for (int k = 0; k < 8; ++k) { const float w = (k < 4 ? w0[i][k & 3] : w1[i][k & 3]) * (1.0f / (float)(1 << FP8_Y_SHIFT));
#pragma unroll
                for (int j = 0; j < 4; ++j) { const f32x2_t lo = __builtin_amdgcn_cvt_pk_f32_fp8((int)y[i][k][j], false), hi = __builtin_amdgcn_cvt_pk_f32_fp8((int)y[i][k][j], true);
                    v[i][j][0] += w * lo.x; v[i][j][1] += w * lo.y; v[i][j][2] += w * hi.x; v[i][j][3] += w * hi.y; } }
            ln_row(v[i]);
#pragma unroll
            for (int j = 0; j < 4; ++j) *(f32x4*)(F.out + (size_t)(t0 + i) * 1024 + 16 * F.lane + 4 * j) = v[i][j] * gg[j] + bb[j]; }
    }
}

__device__ __forceinline__ void phase_h_to_fp8(Frame& F) {
    PHASE_IDS(F);
    constexpr float SC = (float)(1 << FP8_A_SHIFT);
    for (int pm = blockIdx.x; pm < T / 256; pm += gridDim.x) {
        const u32x4* H = WSP(u32x4, WS_H) + (size_t)pm * 256 * 128; u32x2* H8 = WSP(u32x2, WS_H8) + (size_t)pm * 256 * 128;
        for (int i = F.tid; i < 256 * 128; i += 4 * 512) { u32x4 v[4];
#pragma unroll
            for (int j = 0; j < 4; ++j) v[j] = H[i + j * 512];
#pragma unroll
            for (int j = 0; j < 4; ++j) { f32x4 a, b; unpack8(v[j], a, b); u32x2 o; o.x = pk4_fp8(a[0] * SC, a[1] * SC, a[2] * SC, a[3] * SC); o.y = pk4_fp8(b[0] * SC, b[1] * SC, b[2] * SC, b[3] * SC); H8[i + j * 512] = o; } }
    }
    asm volatile("s_waitcnt vmcnt(0)" ::: "memory"); __syncthreads();
}

constexpr int RT_HIST = 0, RT_GS = 1024, RT_RB = 5120, RT_LG = 6144, RT_STRIDE = 257;
static_assert(RT_LG + 128 * RT_STRIDE * 4 <= MISC_OFF, "routing LDS");
__device__ __forceinline__ void route_block(Frame& F, int tb) {
    LAS int* hist = (LAS int*)(F.lds + RT_HIST); LAS float* GS = (LAS float*)(F.lds + RT_GS); LAS float* LS = (LAS float*)(F.lds + RT_LG);
    const float* LG = WSP(float, WS_LG); const float* rb = F.in[18];
    int* IDX = WSP(int, WS_IDX); float* WT = WSP(float, WS_WT); int* RANK = WSP(int, WS_RANK); int* CNT = WSP(int, WS_CNT);
    __syncthreads();
    LAS float* RB = (LAS float*)(F.lds + RT_RB);
    if (F.tid < 256) { hist[F.tid] = 0; RB[F.tid] = rb[F.tid]; }
    const f32x4 rbv = *(const f32x4*)(rb + (F.tid & 63) * 4);
    for (int half = 0; half < 2; ++half) {
        __syncthreads();
        { const f32x4* src = (const f32x4*)(LG + ((size_t)tb * 256 + half * 128) * 256);
          f32x4 lv[16];
#pragma unroll
          for (int i = 0; i < 16; ++i) lv[i] = src[F.tid + 512 * i];
#pragma unroll
          for (int i = 0; i < 16; ++i) { const int q = F.tid + 512 * i; const f32x4 v = lv[i]; const int r = q >> 6, c = (q & 63) * 4; LAS float* d = LS + r * RT_STRIDE + c;
              d[0] = sigmoidf_(v[0]) + rbv[0]; d[1] = sigmoidf_(v[1]) + rbv[1]; d[2] = sigmoidf_(v[2]) + rbv[2]; d[3] = sigmoidf_(v[3]) + rbv[3]; } }
        __syncthreads();
        { const int tok = F.tid >> 2, part = F.tid & 3; LAS float* lg = LS + tok * RT_STRIDE;
#pragma unroll
          for (int gg = 0; gg < 2; ++gg) { const int g = 2 * part + gg; float m1 = -INFINITY, m2 = -INFINITY;
#pragma unroll 8
              for (int i = 0; i < 32; ++i) { const float v = lg[32 * g + ((i + 8 * part) & 31)]; if (v > m1) { m2 = m1; m1 = v; } else if (v > m2) m2 = v; }
              GS[tok * 8 + g] = m1 + m2; } }
        __syncthreads();
        if (F.tid < 128) {
            const int t = tb * 256 + half * 128 + F.tid; LAS float* lg = LS + F.tid * RT_STRIDE;
            float gs[8];
            { const f32x4 g0 = *(const LAS f32x4*)(GS + F.tid * 8), g1 = *(const LAS f32x4*)(GS + F.tid * 8 + 4); gs[0] = g0[0]; gs[1] = g0[1]; gs[2] = g0[2]; gs[3] = g0[3]; gs[4] = g1[0]; gs[5] = g1[1]; gs[6] = g1[2]; gs[7] = g1[3]; }
            unsigned gmask = 0u;
#pragma unroll
            for (int p = 0; p < 4; ++p) { float best = -INFINITY; int bi = 0;
#pragma unroll
                for (int g = 0; g < 8; ++g) { const bool ok = !((gmask >> g) & 1u) && gs[g] > best; best = ok ? gs[g] : best; bi = ok ? g : bi; }
                gmask |= 1u << bi; }
            float tv[8]; int ti[8];
#pragma unroll
            for (int k = 0; k < 8; ++k) { tv[k] = -INFINITY; ti[k] = 0; }
            for (int g = 0; g < 8; ++g) { if (!((gmask >> g) & 1u)) continue;
                for (int i = 0; i < 32; ++i) { const int e = 32 * g + i; float v = lg[e]; int id = e;
                    if (v > tv[7]) {
#pragma unroll
                        for (int k = 0; k < 8; ++k) { const bool sw = v > tv[k]; const float tvk = tv[k]; const int tik = ti[k]; tv[k] = sw ? v : tvk; ti[k] = sw ? id : tik; v = sw ? tvk : v; id = sw ? tik : id; } } } }
            float sc[8], ssum = 0.f;
#pragma unroll
            for (int k = 0; k < 8; ++k) { sc[k] = tv[k] - RB[ti[k]]; ssum += sc[k]; }
            const float inv = 2.5f / ssum;
#pragma unroll
            for (int k = 0; k < 8; ++k) { IDX[(size_t)t * 8 + k] = ti[k]; WT[(size_t)t * 8 + k] = sc[k] * inv; RANK[(size_t)t * 8 + k] = __hip_atomic_fetch_add(&hist[ti[k]], 1, __ATOMIC_RELAXED, __HIP_MEMORY_SCOPE_WORKGROUP); }
        }
    }
    __syncthreads();
    if (F.tid < 256) CNT[tb * 256 + F.tid] = hist[F.tid];
}
__device__ __forceinline__ void phase_route_own(Frame& F) {
    PHASE_IDS(F);
    asm volatile("s_waitcnt vmcnt(0)" ::: "memory"); __syncthreads();
    for (int pm = blockIdx.x; pm < T / 256; pm += gridDim.x) route_block(F, pm);
}
__device__ __forceinline__ void phase_slots(Frame& F) {
    PHASE_IDS(F);
    LAS int* base = (LAS int*)F.lds; LAS int* pad = base + 256; LAS int* tot = base + 512; LAS int* pst = base + 768; LAS int* part = base + 1280;
    const int* IDX = WSP(int, WS_IDX); const int* RANK = WSP(int, WS_RANK); const int* CNT = WSP(int, WS_CNT);
    int* TSLOT = WSP(int, WS_TSLOT); int* STOK = WSP(int, WS_STOK); int* TILE = WSP(int, WS_TILE);
    for (int tb = blockIdx.x; tb < T / 256; tb += gridDim.x) {
        __syncthreads();
        { const int e = F.tid & 255, hh = F.tid >> 8; int run = 0, mine = 0; const int* c = CNT + (size_t)hh * 128 * 256 + e;
#pragma unroll 16
          for (int j = 0; j < 128; ++j) { const int v = c[j * 256]; run += v; mine += (hh * 128 + j < tb) ? v : 0; }
          if (hh) { part[2 * e] = run; part[2 * e + 1] = mine; }
          __syncthreads();
          if (!hh) { run += part[2 * e]; mine += part[2 * e + 1]; base[e] = mine; tot[e] = run; pad[e] = (run + 255) & ~255; } }
        __syncthreads();
        if (F.tid < 64) { const int p0 = pad[4 * F.tid], p1 = pad[4 * F.tid + 1], p2 = pad[4 * F.tid + 2], p3 = pad[4 * F.tid + 3]; const int sl = p0 + p1 + p2 + p3;
            const int incl = (int)wave_incl_scan((float)sl), ex = incl - sl;
            pst[4 * F.tid] = ex; pst[4 * F.tid + 1] = ex + p0; pst[4 * F.tid + 2] = ex + p0 + p1; pst[4 * F.tid + 3] = ex + p0 + p1 + p2; if (F.tid == 63) pst[256] = incl; }
        __syncthreads();
        if (F.tid < 256) {
            const int t = tb * 256 + F.tid;
            const u32x4 i0 = *(const u32x4*)(IDX + (size_t)t * 8), i1 = *(const u32x4*)(IDX + (size_t)t * 8 + 4), r0 = *(const u32x4*)(RANK + (size_t)t * 8), r1 = *(const u32x4*)(RANK + (size_t)t * 8 + 4);
            u32x4 s0, s1;
#pragma unroll
            for (int k = 0; k < 4; ++k) { s0[k] = (unsigned)(pst[i0[k]] + base[i0[k]]) + r0[k]; s1[k] = (unsigned)(pst[i1[k]] + base[i1[k]]) + r1[k]; }
            *(u32x4*)(TSLOT + (size_t)t * 8) = s0; *(u32x4*)(TSLOT + (size_t)t * 8 + 4) = s1;
            const int rowidx = (t >> 8) * 512 + (t & 255);
#pragma unroll
            for (int k = 0; k < 4; ++k) { STOK[s0[k]] = rowidx; STOK[s1[k]] = rowidx; }
            if (F.tid == 0) { const int e = tb; for (int sp = pst[e] + tot[e]; sp < pst[e] + pad[e]; ++sp) STOK[sp] = 0;
                for (int tl = pst[e] >> 8; tl < (pst[e] + pad[e]) >> 8; ++tl) TILE[tl] = e;
                if (e == 0) TILE[4096] = pst[256] >> 8; }
        }
    }
}

#if GEMM_FAST
#define GEMM_PHASE(lds_, pv_, ep_) gemm_phase_pg8<decltype(pv_), decltype(ep_), PG_ALIGN, PG_SP2>(lds_, pv_, ep_, F.tid)
#define GEMM_PHASE_NA(lds_, pv_, ep_) gemm_phase_pg8<decltype(pv_), decltype(ep_), false, PG_SP2>(lds_, pv_, ep_, F.tid)
#else
#define GEMM_PHASE(lds_, pv_, ep_) gemm_phase_simple(lds_, pv_, ep_, F.tid)
#define GEMM_PHASE_NA(lds_, pv_, ep_) gemm_phase_simple(lds_, pv_, ep_, F.tid)
#endif
enum { PH_PRO = 0, PH_INPROJ, PH_MIX, PH_MERGE, PH_MID, PH_SLOTS, PH_GU, PH_DOWN, PH_COMB, PH_COUNT };

template <int LO, int HI>
__global__ void __launch_bounds__(512, 2) mega(const Params prm) {
    extern __shared__ __attribute__((aligned(16))) unsigned char lds_raw[];
    Frame F;
    F.lds = (LAS unsigned char*)lds_raw; F.tid = threadIdx.x; F.lane = F.tid & 63; F.wave = __builtin_amdgcn_readfirstlane(F.tid >> 6);
    F.in = prm.in; F.out = prm.out; F.ws = prm.ws;
    volatile LAS unsigned* MISC = (volatile LAS unsigned*)(F.lds + MISC_OFF);
    constexpr bool MULTI = (HI - LO > 1);
    XcdBarrier bar; bar.bar = (unsigned*)(F.ws + WS_CTL) + CW_BAR; bar.x = 0; bar.st = MISC + 8;
    if (F.tid < 32) MISC[F.tid] = 0u;
    __syncthreads();
    if constexpr (MULTI) bar = xcd_barrier_post((unsigned*)(F.ws + WS_CTL) + CW_BAR, MISC + 8, F.tid);
#define IN(k) (LO <= (k) && (k) < HI)
#define SEAM(k) do { if constexpr (IN(k) && IN((k) + 1)) xcd_barrier(bar, F.tid); } while (0)

    if constexpr (IN(PH_PRO)) { for (int rep_ = 0; rep_ < (PROBE_PHASE == PH_PRO ? 2 : 1); ++rep_) { if (rep_) xcd_barrier(bar, F.tid); phase_prologue(F); } } SEAM(PH_PRO);
#if INPROJ_FP8
    if constexpr (IN(PH_INPROJ)) { ProvDense8 pv{(const unsigned char*)F.out + (size_t)T * 2048, WSP(unsigned char, WS_WIN), 1024, 256, 29}; EpiInProj ep{WSP(bf16, WS_P), WSP(float, WS_GL), F.lds}; GEMM_PHASE(F.lds, pv, ep); } SEAM(PH_INPROJ);
#else
    if constexpr (IN(PH_INPROJ)) { for (int rep_ = 0; rep_ < (PROBE_PHASE == PH_INPROJ ? 2 : 1); ++rep_) { if (rep_) xcd_barrier(bar, F.tid); ProvDense pv{(const bf16*)F.out, WSP(bf16, WS_WIN), 1024, 1024, 256, 29}; EpiInProj ep{WSP(bf16, WS_P), WSP(float, WS_GL), F.lds}; GEMM_PHASE(F.lds, pv, ep); } } SEAM(PH_INPROJ);
#endif
    if constexpr (IN(PH_MIX)) { phase_mixers(F, MISC); } SEAM(PH_MIX);
    if constexpr (IN(PH_MERGE)) {
        { ProvPanel8 pv{(const unsigned char*)F.out, WSP(unsigned char, WS_WA), 1024, 256, 4, H8_PANEL}; EpiGateMul ep{WSP(bf16, WS_P), C_GTA, nullptr, nullptr, WSP(unsigned char, WS_H), H8_PANEL, F.lds}; GEMM_PHASE(F.lds, pv, ep); }
        asm volatile("s_waitcnt vmcnt(0)" ::: "memory"); __syncthreads();
        { ProvPanel8 pv{(const unsigned char*)F.out + 262144, WSP(unsigned char, WS_WB), 1024, 256, 4, H8_PANEL}; EpiGateMul ep{WSP(bf16, WS_P), C_GTB, WSP(unsigned char, WS_H), nullptr, (unsigned char*)F.out + (size_t)T * 2048, 256 * 1024, F.lds}; GEMM_PHASE(F.lds, pv, ep); }
        asm volatile("s_waitcnt vmcnt(0)" ::: "memory"); __syncthreads();
        { ProvPanel8 pv{(const unsigned char*)F.out + (size_t)T * 2048, WSP(unsigned char, WS_WO), 1024, 256, 4, 256 * 1024}; EpiHpre ep{F.in[0], WSP(bf16, WS_H), F.lds}; GEMM_PHASE(F.lds, pv, ep); }
        asm volatile("s_waitcnt vmcnt(0)" ::: "memory"); __syncthreads();
        for (int pm = blockIdx.x; pm < T / 256; pm += gridDim.x) ln1_rows(F, pm * 256, 256);
    } SEAM(PH_MERGE);
    if constexpr (IN(PH_MID)) for (int rep_ = 0; rep_ < (PROBE_PHASE == PH_MID ? 2 : 1); ++rep_) {
        if (rep_) xcd_barrier(bar, F.tid);
        const bool conv_first = (blockIdx.x & 1) != 0;
        if (conv_first) phase_expert_convert(F);
        { ProvPanel pv{WSP(bf16, WS_H), WSP(bf16, WS_WR), 1024, 1024, 256, 1}; EpiF32 ep{WSP(float, WS_LG), 256, F.lds}; GEMM_PHASE(F.lds, pv, ep); phase_route_own(F); }
        { ProvPanel8 pv{(const unsigned char*)F.out, WSP(unsigned char, WS_WSGU), 1024, 256, 2, H8_PANEL}; EpiSwiglu8 ep{WSP(unsigned char, WS_ACTSH), F.lds}; GEMM_PHASE(F.lds, pv, ep); }
        asm volatile("s_waitcnt vmcnt(0)" ::: "memory"); __syncthreads();
        { ProvPanel8 pv{WSP(unsigned char, WS_ACTSH), WSP(unsigned char, WS_WSD), 256, 256, 4, 256 * 256}; EpiShDown ep{WSP(bf16, WS_H), F.lds}; GEMM_PHASE(F.lds, pv, ep); }
        if (!conv_first) phase_expert_convert(F);
    } SEAM(PH_MID);
    if constexpr (IN(PH_SLOTS)) { for (int rep_ = 0; rep_ < (PROBE_PHASE == PH_SLOTS ? 2 : 1); ++rep_) { if (rep_) xcd_barrier(bar, F.tid); phase_slots(F); } } SEAM(PH_SLOTS);
    if constexpr (IN(PH_GU)) { for (int rep_ = 0; rep_ < (PROBE_PHASE == PH_GU ? 2 : 1); ++rep_) { if (rep_) xcd_barrier(bar, F.tid); const int ntl = __builtin_amdgcn_readfirstlane(WSP(int, WS_TILE)[4096]); ProvGateUp pv{(const unsigned char*)F.out, WSP(unsigned char, WS_WGU8), WSP(int, WS_STOK), WSP(int, WS_TILE), ntl, (LAS int*)(F.lds + PG_TAB_OFF)}; EpiSwiglu8 ep{WSP(unsigned char, WS_ACT8), F.lds}; GEMM_PHASE(F.lds, pv, ep); } } SEAM(PH_GU);
    if constexpr (IN(PH_DOWN)) { const int ntl = __builtin_amdgcn_readfirstlane(WSP(int, WS_TILE)[4096]);
        { ProvDown pv{WSP(unsigned char, WS_ACT8), WSP(unsigned char, WS_WD8), WSP(int, WS_TILE), ntl, 0, (LAS int*)(F.lds + PG_TAB_OFF)}; EpiFp8Tile ep{WSP(unsigned char, WS_Y8), F.lds}; GEMM_PHASE(F.lds, pv, ep); }
        { ProvDown pv{WSP(unsigned char, WS_ACT8), WSP(unsigned char, WS_WD8), WSP(int, WS_TILE), ntl, 1, (LAS int*)(F.lds + PG_TAB_OFF)}; EpiFp8Tile ep{WSP(unsigned char, WS_Y8), F.lds}; GEMM_PHASE(F.lds, pv, ep); } } SEAM(PH_DOWN);
    if constexpr (IN(PH_COMB)) { phase_combine(F); }
#undef IN
#undef SEAM
}
}

extern "C" void kernel_launch(void* const* d_in, const int* in_sizes, int n_in, void* d_out, int out_size, void* d_ws, size_t ws_size, hipStream_t stream) {
    static int grid = 0;
    if (grid == 0) {
        if (n_in != 27 || in_sizes[0] != T * D || out_size != T * D || ws_size < WS_END) { fprintf(stderr, "kernel_launch: unexpected problem (n_in %d, in0 %d, out %d, ws %zu < %zu); nothing launched\n", n_in, n_in > 0 ? in_sizes[0] : -1, out_size, ws_size, (size_t)WS_END); grid = -1; return; }
        int dev = 0, cus = 0;
        if (hipGetDevice(&dev) != hipSuccess || hipDeviceGetAttribute(&cus, hipDeviceAttributeMultiprocessorCount, dev) != hipSuccess) { grid = -1; return; }
        grid = cus;
    }
    if (grid < 0) return;
    (void)hipMemsetAsync((char*)d_ws + WS_CTL, 0, CTL_BYTES, stream);
    Params p{};
    for (int i = 0; i < 27; ++i) p.in[i] = (const float*)d_in[i];
    p.out = (float*)d_out; p.ws = (unsigned char*)d_ws; p.q_lo = 0; p.q_hi = 2;
#define LAUNCH(LO_, HI_) do { static bool attr_ = false; if (!attr_) { (void)hipFuncSetAttribute((const void*)mega<LO_, HI_>, hipFuncAttributeMaxDynamicSharedMemorySize, LDS_BYTES); attr_ = true; } \
        hipLaunchKernelGGL((mega<LO_, HI_>), dim3(grid), dim3(512), LDS_BYTES, stream, p); } while (0)
#if MK_N_LAUNCHES == 1
    LAUNCH(0, PH_COUNT);
#else
    LAUNCH(0, 1); LAUNCH(1, 2); LAUNCH(2, 3); LAUNCH(3, 4); LAUNCH(4, 5); LAUNCH(5, 6); LAUNCH(6, 7);
    LAUNCH(7, 8); LAUNCH(8, 9);
#endif
}
```

```cpp
#include <hip/hip_runtime.h>
#include <cstdio>
#include <cstdint>

#ifndef GEMM_FAST
#define GEMM_FAST 1
#endif
#ifndef PG_SP2
#define PG_SP2 true
#endif
#ifndef PG_ALIGN
#define PG_ALIGN true
#endif
#ifndef PROBE_PHASE
#define PROBE_PHASE -1
#endif
#ifndef INPROJ_FP8
#define INPROJ_FP8 1
#endif
#ifndef MK_N_LAUNCHES
#define MK_N_LAUNCHES 1
#endif

namespace {
#define LAS __attribute__((address_space(3)))
typedef unsigned short bf16;
typedef short bf16x8 __attribute__((ext_vector_type(8)));
typedef float f32x4 __attribute__((ext_vector_type(4)));
typedef unsigned u32x4 __attribute__((ext_vector_type(4)));
typedef unsigned u32x2 __attribute__((ext_vector_type(2)));
typedef int v4i __attribute__((ext_vector_type(4)));
typedef int v8i __attribute__((ext_vector_type(8)));

constexpr int T = 65536, D = 1024, SEQ = 2048;
constexpr int NPT = 28;
constexpr int C_XA = 0, C_GA = 1024, C_Q = 2048, C_K = 2560, C_V = 3072, C_R = 4096, C_GTA = 5120, C_GTB = 6144;
constexpr int NIN = 7424;
constexpr int DIN = 7184;
constexpr int NE = 256, TOPK = 8, DE = 256;
constexpr int SMAX = T * TOPK + NE * 256;
constexpr float DN_ALPHA = 1.189207115002721f;
constexpr float LN_EPS = 1e-5f, RMS_EPS = 1e-6f;

constexpr size_t MiB = 1u << 20;
constexpr size_t WS_CTL = 0, CTL_BYTES = 1 * MiB;
constexpr size_t WS_WIN = 1 * MiB;
constexpr size_t WS_WA = 16 * MiB, WS_WB = 18 * MiB, WS_WO = 20 * MiB;
constexpr size_t WS_WR = 22 * MiB;
constexpr size_t WS_WSGU = WS_WR + MiB / 2;
constexpr size_t WS_WSD = WS_WSGU + MiB;
constexpr size_t WS_LRUW = 24 * MiB;
constexpr size_t WS_GL = 25 * MiB;
constexpr size_t WS_H = 29 * MiB;
constexpr size_t WS_P = 157 * MiB;
constexpr size_t WS_END = WS_P + (size_t)896 * MiB;
constexpr size_t WS_WD8 = WS_P;
constexpr size_t WS_ACT8 = WS_P + 64 * MiB;
constexpr size_t WS_IDX = WS_P + 208 * MiB;
constexpr size_t WS_WT = WS_IDX + 2 * MiB;
constexpr size_t WS_RANK = WS_WT + 2 * MiB;
constexpr size_t WS_TSLOT = WS_RANK + 2 * MiB;
constexpr size_t WS_STOK = WS_TSLOT + 2 * MiB;
constexpr size_t WS_CNT = WS_STOK + 3 * MiB;
constexpr size_t WS_TILE = WS_CNT + 1 * MiB;
constexpr size_t WS_Y8 = WS_P + 320 * MiB;
constexpr size_t WS_WGU8 = WS_P + 320 * MiB;
constexpr int H8_PANEL = 256 * 2048;
constexpr size_t WS_H8 = WS_P + 224 * MiB;
constexpr size_t WS_LG = WS_P + 576 * MiB;
constexpr size_t WS_ACTSH = WS_P + 640 * MiB;
static_assert(WS_TILE + MiB <= WS_H8 && WS_H8 + 64 * MiB <= WS_Y8 && WS_Y8 + (size_t)SMAX * 1024 <= WS_END && WS_ACTSH + 32 * MiB <= WS_END, "MoE overlay map");
constexpr int FP8_Y_SHIFT = 5;
constexpr int FP8_W_SHIFT = 6, FP8_A_SHIFT = 3;

constexpr int CW_BAR = 4096, CW_MIXQ = 64;

constexpr int LDS_BYTES = 163840;
constexpr int MISC_OFF = LDS_BYTES - 256;

__device__ __forceinline__ size_t pt_off(size_t row, int col) { return (((row >> 8) * NPT + (size_t)(col >> 8)) << 16) + ((row & 255) << 8) + (size_t)(col & 255); }
__device__ __forceinline__ float bf2f(unsigned b) { return __uint_as_float(b << 16); }
typedef float f32x2_t __attribute__((ext_vector_type(2)));
typedef __bf16 bf16x2_t __attribute__((ext_vector_type(2)));
__device__ __forceinline__ unsigned cvt_pk_bf16(float lo, float hi) { const f32x2_t v = {lo, hi}; const bf16x2_t b = __builtin_convertvector(v, bf16x2_t); return __builtin_bit_cast(unsigned, b); }
__device__ __forceinline__ unsigned pk2(float lo, float hi) { return cvt_pk_bf16(lo, hi); }
__device__ __forceinline__ unsigned f2bf(float f) { return cvt_pk_bf16(f, f) & 0xffffu; }
__device__ __forceinline__ float lo16(unsigned w) { return __uint_as_float(w << 16); }
__device__ __forceinline__ float hi16(unsigned w) { return __uint_as_float(w & 0xffff0000u); }
__device__ __forceinline__ float sigmoidf_(float x) { return __builtin_amdgcn_rcpf(1.0f + __expf(-x)); }
__device__ __forceinline__ float siluf_(float x) { return x * sigmoidf_(x); }
__device__ __forceinline__ float gelu_tanh(float x) { return x * sigmoidf_(1.5957691216057308f * (x + 0.044715f * x * x * x)); }

__device__ __forceinline__ float lane_read(float v, int src_lane) { return __int_as_float(__builtin_amdgcn_ds_bpermute(src_lane << 2, __float_as_int(v))); }
template <int N> __device__ __forceinline__ float dpp_row_shr(float v, float oob) { return __int_as_float(__builtin_amdgcn_update_dpp(__float_as_int(oob), __float_as_int(v), 0x110 + N, 0xF, 0xF, false)); }
__device__ __forceinline__ float wave_incl_scan(float v) {
    v += dpp_row_shr<1>(v, 0.f); v += dpp_row_shr<2>(v, 0.f); v += dpp_row_shr<4>(v, 0.f); v += dpp_row_shr<8>(v, 0.f);
    v += __int_as_float(__builtin_amdgcn_update_dpp(0, __float_as_int(v), 0x142, 0xA, 0xF, false));
    v += __int_as_float(__builtin_amdgcn_update_dpp(0, __float_as_int(v), 0x143, 0xC, 0xF, false));
    return v;
}
#define XB_TMO      128
#define XB_XCNT(j)  (256  + 64 * (j))
#define XB_XSUB(j)  (1280 + 64 * (j))
#define XB_XGEN(j)  (2304 + 64 * (j))
#define XB_TOP      3328
#define XB_TOPGEN   3392
#define XCD_BAR_WORDS 3456
#define XB_SPIN_CAP (1u << 18)
__device__ __forceinline__ unsigned xb_ld(unsigned* p)              { return __hip_atomic_load(p, __ATOMIC_RELAXED, __HIP_MEMORY_SCOPE_AGENT); }
__device__ __forceinline__ unsigned xb_add(unsigned* p, unsigned v) { return __hip_atomic_fetch_add(p, v, __ATOMIC_RELAXED, __HIP_MEMORY_SCOPE_AGENT); }
__device__ __forceinline__ unsigned xb_xcc_id() { return (unsigned)__builtin_amdgcn_s_getreg((3 << 11) | 20) & 0xFu; }
#define XB_SPIN(cond, bar) do { unsigned _sp = 0; while (cond) { __builtin_amdgcn_s_sleep(1); \
    if ((++_sp & 255u) == 0u) { if (xb_ld(&(bar)[XB_TMO])) break; if (_sp > XB_SPIN_CAP) { atomicAdd(&(bar)[XB_TMO], 1u); break; } } } } while (0)
struct XcdBarrier { unsigned* bar; unsigned x; volatile LAS unsigned* st; };
__device__ __forceinline__ XcdBarrier xcd_barrier_post(unsigned* bar, volatile LAS unsigned* st, int tid) {
    XcdBarrier b; b.bar = bar; b.x = xb_xcc_id(); b.st = st;
    if (tid == 0) (void)xb_add(&bar[XB_XCNT(b.x)], 1u);
    return b;
}
__device__ __forceinline__ void xcd_barrier_complete(unsigned* bar, unsigned x, unsigned& nloc, unsigned& nx) {
    const unsigned G = gridDim.x * gridDim.y * gridDim.z;
    unsigned sum, cnt, mine, sp = 0u;
    for (;;) {
        sum = 0u; cnt = 0u; mine = 0u;
#pragma unroll
        for (unsigned j = 0; j < 16; ++j) { const unsigned c = xb_ld(&bar[XB_XCNT(j)]); sum += c; cnt += (c > 0u) ? 1u : 0u; mine = (j == x) ? c : mine; }
        if (sum == G) break;
        __builtin_amdgcn_s_sleep(1);
        if ((++sp & 255u) == 0u) { if (xb_ld(&bar[XB_TMO])) break; if (sp > XB_SPIN_CAP) { atomicAdd(&bar[XB_TMO], 1u); break; } }
    }
    nloc = mine > 0u ? mine : 1u; nx = cnt > 0u ? cnt : 1u;
}
__device__ __forceinline__ void xcd_barrier(const XcdBarrier& b, int tid) {
    asm volatile("s_waitcnt vmcnt(0)" ::: "memory");
    __syncthreads();
    if (tid == 0) {
        unsigned* bar = b.bar;
        __builtin_amdgcn_s_waitcnt(0);
        unsigned nloc = b.st[0], nx = b.st[1];
        if (nloc == 0u) { xcd_barrier_complete(bar, b.x, nloc, nx); b.st[0] = nloc; b.st[1] = nx; }
        const unsigned old = xb_add(&bar[XB_XSUB(b.x)], 1u);
        const unsigned gen = old / nloc;
        if (old + 1u == (gen + 1u) * nloc) {
            __builtin_amdgcn_fence(__ATOMIC_RELEASE, "agent");
            asm volatile("s_waitcnt vmcnt(0)" ::: "memory");
            const unsigned og = xb_add(&bar[XB_TOP], 1u);
            const unsigned tg = og / nx;
            if (og + 1u == (tg + 1u) * nx) xb_add(&bar[XB_TOPGEN], 1u);
            else XB_SPIN(xb_ld(&bar[XB_TOPGEN]) == tg, bar);
            __builtin_amdgcn_fence(__ATOMIC_ACQUIRE, "agent");
            xb_add(&bar[XB_XGEN(b.x)], 1u);
            asm volatile("s_waitcnt vmcnt(0)" ::: "memory");
        } else {
            XB_SPIN(xb_ld(&bar[XB_XGEN(b.x)]) == gen, bar);
            __builtin_amdgcn_fence(__ATOMIC_ACQUIRE, "agent");
            asm volatile("s_waitcnt vmcnt(0)" ::: "memory");
        }
    }
    __syncthreads();
}

struct Params { const float* in[27]; float* out; unsigned char* ws; int q_lo, q_hi; };

struct Frame {
    LAS unsigned char* lds;
    int tid, lane, wave;
    const float* const* in;
    float* out; unsigned char* ws;
};
#define WSP(T_, off) ((T_*)(F.ws + (off)))
#define PHASE_IDS(F) do { asm volatile("" : "+v"((F).tid)); (F).lane = (F).tid & 63; (F).wave = __builtin_amdgcn_readfirstlane((F).tid >> 6); } while (0)

__device__ __forceinline__ unsigned pk4_fp8(float a, float b, float c, float d) { int w = 0; w = __builtin_amdgcn_cvt_pk_fp8_f32(a, b, w, false); w = __builtin_amdgcn_cvt_pk_fp8_f32(c, d, w, true); return (unsigned)w; }
__device__ __forceinline__ void tr8_load(f32x4 (&v)[16], const float* src, int ld, int k0, int n0, int lane) {
    const int lr = lane >> 4, lc = (lane & 15) * 4;
#pragma unroll
    for (int i = 0; i < 16; ++i) v[i] = __builtin_nontemporal_load((const f32x4*)(src + (size_t)(k0 + 16 * lr + i) * ld + n0 + lc));
}
__device__ __forceinline__ void tr8_store(const f32x4 (&v)[16], int k0, unsigned char* dst, int dstK, int drow0, int lane, float scale) {
    const int lr = lane >> 4, lc = (lane & 15) * 4;
#pragma unroll
    for (int j = 0; j < 4; ++j) { u32x4 o;
#pragma unroll
        for (int q = 0; q < 4; ++q) o[q] = pk4_fp8(v[4 * q][j] * scale, v[4 * q + 1][j] * scale, v[4 * q + 2][j] * scale, v[4 * q + 3][j] * scale);
        *(u32x4*)(dst + (size_t)(drow0 + lc + j) * dstK + k0 + 16 * lr) = o; }
}
__device__ __forceinline__ void tr_item8(const float* src, int ld, int k0, int n0, unsigned char* dst, int dstK, int drow0, LAS unsigned char*  , int lane, float scale) {
    f32x4 v[16]; tr8_load(v, src, ld, k0, n0, lane); tr8_store(v, k0, dst, dstK, drow0, lane, scale);
}

__device__ __forceinline__ void tr_item(const float* src, int ld, int k0, int n0, bf16* dst, int dstK, int drow0, LAS bf16* scr, int lane) {
    const int lr = lane >> 4, lc = (lane & 15) * 4;
    f32x4 v[16];
#pragma unroll
    for (int i = 0; i < 16; ++i) v[i] = *(const f32x4*)(src + (size_t)(k0 + 4 * i + lr) * ld + n0 + lc);
#pragma unroll
    for (int i = 0; i < 16; ++i) { const int k = 4 * i + lr;
        scr[(lc + 0) * 66 + k] = (bf16)f2bf(v[i][0]); scr[(lc + 1) * 66 + k] = (bf16)f2bf(v[i][1]); scr[(lc + 2) * 66 + k] = (bf16)f2bf(v[i][2]); scr[(lc + 3) * 66 + k] = (bf16)f2bf(v[i][3]); }
    asm volatile("s_waitcnt lgkmcnt(0)" ::: "memory");
#pragma unroll
    for (int j = 0; j < 8; ++j) { const int n = 8 * j + (lane >> 3), c = (lane & 7) * 8;
        const LAS unsigned* p = (const LAS unsigned*)(scr + n * 66 + c); u32x4 o; o.x = p[0]; o.y = p[1]; o.z = p[2]; o.w = p[3];
        *(u32x4*)(dst + (size_t)(drow0 + n) * dstK + k0 + c) = o; }
    asm volatile("s_waitcnt lgkmcnt(0)" ::: "memory");
}

__device__ __forceinline__ void phase_prologue(Frame& F) {
    PHASE_IDS(F);
    const int gw = blockIdx.x * 8 + F.wave, NGW = gridDim.x * 8;
    LAS bf16* scr = (LAS bf16*)(F.lds + F.wave * 16384);
    { const f32x4* x4 = (const f32x4*)F.in[0]; u32x4* xb = (u32x4*)F.out;
      const size_t n8 = (size_t)T * D / 8, gt = (size_t)blockIdx.x * 512 + F.tid, GT = (size_t)gridDim.x * 512;
      for (size_t i = gt; i < n8; i += 4 * GT) { f32x4 a[4], b[4];
#pragma unroll
          for (int j = 0; j < 4; ++j) { a[j] = x4[2 * (i + j * GT)]; b[j] = x4[2 * (i + j * GT) + 1]; }
#pragma unroll
          for (int j = 0; j < 4; ++j) {
#if !INPROJ_FP8
              u32x4 o; o.x = pk2(a[j].x, a[j].y); o.y = pk2(a[j].z, a[j].w); o.z = pk2(b[j].x, b[j].y); o.w = pk2(b[j].z, b[j].w); xb[i + j * GT] = o;
#else
              constexpr float SC = (float)(1 << FP8_A_SHIFT); u32x2 o8; o8.x = pk4_fp8(a[j].x * SC, a[j].y * SC, a[j].z * SC, a[j].w * SC); o8.y = pk4_fp8(b[j].x * SC, b[j].y * SC, b[j].z * SC, b[j].w * SC);
              ((u32x2*)((unsigned char*)F.out + (size_t)T * 2048))[i + j * GT] = o8;
#endif
          } } }
    constexpr int I_IN = 16 * 112, I_SQ = 16 * 16, I_R = 16 * 4, I_SG = 16 * 4, I_SD = 4 * 16;
    constexpr int NITEMS = I_IN + 3 * I_SQ + I_R + 2 * I_SG + I_SD;
    for (int it = gw; it < NITEMS; it += NGW) {
        int r = it;
        if (r < I_IN) { const int kb = r / 112, nb = r % 112; const int n0d = 64 * nb, n0s = n0d + (n0d >= 5120 ? 16 : 0);
#if INPROJ_FP8
            tr_item8(F.in[1], DIN, 64 * kb, n0s, WSP(unsigned char, WS_WIN), 1024, n0d, (LAS unsigned char*)scr, F.lane, (float)(1 << FP8_W_SHIFT)); continue; } r -= I_IN;
#else
            tr_item(F.in[1], DIN, 64 * kb, n0s, WSP(bf16, WS_WIN), 1024, n0d, scr, F.lane); continue; } r -= I_IN;
#endif
        if (r < I_SQ) { tr_item8(F.in[9], 1024, 64 * (r / 16), 64 * (r % 16), WSP(unsigned char, WS_WA), 1024, 64 * (r % 16), (LAS unsigned char*)scr, F.lane, (float)(1 << FP8_W_SHIFT)); continue; } r -= I_SQ;
        if (r < I_SQ) { tr_item8(F.in[13], 1024, 64 * (r / 16), 64 * (r % 16), WSP(unsigned char, WS_WB), 1024, 64 * (r % 16), (LAS unsigned char*)scr, F.lane, (float)(1 << FP8_W_SHIFT)); continue; } r -= I_SQ;
        if (r < I_SQ) { tr_item8(F.in[14], 1024, 64 * (r / 16), 64 * (r % 16), WSP(unsigned char, WS_WO), 1024, 64 * (r % 16), (LAS unsigned char*)scr, F.lane, (float)(1 << FP8_W_SHIFT)); continue; } r -= I_SQ;
        if (r < I_R) { tr_item(F.in[17], 256, 64 * (r / 4), 64 * (r % 4), WSP(bf16, WS_WR), 1024, 64 * (r % 4), scr, F.lane); continue; } r -= I_R;
        if (r < I_SG) { const int nb = r % 4; tr_item8(F.in[22], 256, 64 * (r / 4), 64 * nb, WSP(unsigned char, WS_WSGU), 1024, (nb >> 1) * 256 + (nb & 1) * 64, (LAS unsigned char*)scr, F.lane, (float)(1 << FP8_W_SHIFT)); continue; } r -= I_SG;
        if (r < I_SG) { const int nb = r % 4; tr_item8(F.in[23], 256, 64 * (r / 4), 64 * nb, WSP(unsigned char, WS_WSGU), 1024, (nb >> 1) * 256 + 128 + (nb & 1) * 64, (LAS unsigned char*)scr, F.lane, (float)(1 << FP8_W_SHIFT)); continue; } r -= I_SG;
        tr_item8(F.in[24], 1024, 64 * (r / 16), 64 * (r % 16), WSP(unsigned char, WS_WSD), 256, 64 * (r % 16), (LAS unsigned char*)scr, F.lane, (float)(1 << FP8_W_SHIFT));
    }
    { const size_t gt = (size_t)blockIdx.x * 512 + F.tid, GT = (size_t)gridDim.x * 512; bf16* wi = WSP(bf16, WS_WIN);
      for (size_t i = gt; i < (size_t)256 * 1024; i += GT) { const int rr = (int)(i >> 10), k = (int)(i & 1023);
#if INPROJ_FP8
          ((unsigned char*)wi)[(size_t)(7168 + rr) * 1024 + k] = rr < 16 ? (unsigned char)(pk4_fp8(F.in[1][(size_t)k * DIN + 5120 + rr] * (float)(1 << FP8_W_SHIFT), 0.f, 0.f, 0.f) & 0xffu) : (unsigned char)0; }
#else
          wi[(size_t)(7168 + rr) * 1024 + k] = rr < 16 ? (bf16)f2bf(F.in[1][(size_t)k * DIN + 5120 + rr]) : (bf16)0; }
#endif
      bf16* lw = WSP(bf16, WS_LRUW);
      for (size_t i = gt; i < (size_t)2 * 65536; i += GT) { const int gate = (int)(i >> 16), r2 = (int)(i & 65535), g = r2 >> 12, n = (r2 >> 6) & 63, k = r2 & 63;
          const float* w = gate ? F.in[6] : F.in[4];
          lw[((size_t)(g * 2 + gate) * 64 + n) * 64 + k] = (bf16)f2bf(w[(size_t)g * 4096 + k * 64 + n]); } }
}

struct EconvItem { const float* src; unsigned char* dst; int ld, k0, n0, dstK, drow0; };
__device__ __forceinline__ EconvItem econv_item(Frame& F, int r) {
    constexpr int I_G = 256 * 16 * 4;
    EconvItem it;
    if (r < 2 * I_G) { const int up = r >= I_G; if (up) r -= I_G; const int e = r >> 6, kb = (r >> 2) & 15, nb = r & 3;
        it.src = F.in[up ? 20 : 19] + (size_t)e * 1024 * 256; it.ld = 256; it.k0 = 64 * kb; it.n0 = 64 * nb; it.dst = WSP(unsigned char, WS_WGU8) + (size_t)e * 512 * 1024; it.dstK = 1024; it.drow0 = (nb >> 1) * 256 + up * 128 + (nb & 1) * 64; }
    else { r -= 2 * I_G; const int e = r >> 6, kb = (r >> 4) & 3, nb = r & 15;
        it.src = F.in[21] + (size_t)e * 256 * 1024; it.ld = 1024; it.k0 = 64 * kb; it.n0 = 64 * nb; it.dst = WSP(unsigned char, WS_WD8) + (size_t)e * 1024 * 256; it.dstK = 256; it.drow0 = 64 * nb; }
    return it;
}
__device__ __forceinline__ void phase_expert_convert(Frame& F) {
    PHASE_IDS(F);
    __syncthreads();
    const int gw = blockIdx.x * 8 + F.wave, NGW = gridDim.x * 8;
    constexpr int NIT = 2 * 256 * 16 * 4 + 256 * 4 * 16; constexpr float SC = (float)(1 << FP8_W_SHIFT);
#pragma unroll 1
    for (int r = gw; r < NIT; r += 2 * NGW) {
        const EconvItem ia = econv_item(F, r); f32x4 va[16]; tr8_load(va, ia.src, ia.ld, ia.k0, ia.n0, F.lane);
        if (r + NGW < NIT) { const EconvItem ib = econv_item(F, r + NGW); f32x4 vb[16]; tr8_load(vb, ib.src, ib.ld, ib.k0, ib.n0, F.lane);
            tr8_store(va, ia.k0, ia.dst, ia.dstK, ia.drow0, F.lane, SC); tr8_store(vb, ib.k0, ib.dst, ib.dstK, ib.drow0, F.lane, SC); }
        else tr8_store(va, ia.k0, ia.dst, ia.dstK, ia.drow0, F.lane, SC);
    }
}

__device__ __forceinline__ int pg_perm_row(int r) { const int rho = r & 31, n = rho >> 4, i = rho & 15; return (r & ~31) + 8 * (i >> 2) + 4 * n + (i & 3); }
struct GUnit { const bf16* A; const bf16* Bt; const int* gat; int pm, pn; };

__device__ __forceinline__ void glds16(const void* g, LAS unsigned char* l) { __builtin_amdgcn_global_load_lds((const unsigned*)g, (LAS unsigned*)l, 16, 0, 0); }

template <class Prov, class Epi>
__device__ __forceinline__ void gemm_phase_simple(LAS unsigned char* lds, const Prov& PV, const Epi& E, int& tid_m) {
    asm volatile("" : "+v"(tid_m)); const int tid = tid_m;
    const int wid = __builtin_amdgcn_readfirstlane(tid >> 6), lane = tid & 63;
    const int wr = wid >> 2, wc = wid & 3, fr = lane & 15, fq = lane >> 4;
    static_assert(!Prov::ATILED && !Prov::FP8, "the simple body has no tiled-A / fp8 path");
    const int nun = PV.count();
    for (int i = 0; Prov::LOCAL ? (i < nun) : (i * (int)gridDim.x + (int)blockIdx.x < nun); ++i) {
        static_assert(!Prov::TABLE || true, ""); GUnit g; if constexpr (Prov::TABLE) { __syncthreads(); if (tid == 0) PV.tab[0] = PV.tab_val(i * (int)gridDim.x + (int)blockIdx.x); __syncthreads(); PV.get(i * (int)gridDim.x + (int)blockIdx.x, g, 0); } else PV.get(Prov::LOCAL ? i : i * (int)gridDim.x + (int)blockIdx.x, g);
        const int r0 = tid >> 2, c8 = (tid & 3) * 8;
        long ra0 = r0, ra1 = r0 + 128;
        if (g.gat) { ra0 = g.gat[r0]; ra1 = g.gat[r0 + 128]; }
        const bf16* pa0 = g.A + ra0 * PV.lda_() + c8; const bf16* pa1 = g.A + ra1 * PV.lda_() + c8;
        const bf16* pb0 = g.Bt + (long)pg_perm_row(r0) * PV.ldb_() + c8; const bf16* pb1 = g.Bt + (long)pg_perm_row(r0 + 128) * PV.ldb_() + c8;
        f32x4 acc[2][2][4][2];
#pragma unroll
        for (int a = 0; a < 2; ++a)
#pragma unroll
            for (int b = 0; b < 2; ++b)
#pragma unroll
                for (int m = 0; m < 4; ++m)
#pragma unroll
                    for (int n = 0; n < 2; ++n) acc[a][b][m][n] = (f32x4){0.f, 0.f, 0.f, 0.f};
        const int nt = PV.kdim() >> 5;
#define GS_STG(t, buf) do { LAS unsigned char* d_ = lds + (buf) * 32768 + wid * 1024; \
        glds16(pa0 + (t) * 32, d_); glds16(pa1 + (t) * 32, d_ + 8192); glds16(pb0 + (t) * 32, d_ + 16384); glds16(pb1 + (t) * 32, d_ + 24576); } while (0)
        GS_STG(0, 0);
        for (int t = 0; t < nt; ++t) {
            const int buf = t & 1;
            asm volatile("s_waitcnt vmcnt(0)" ::: "memory"); __syncthreads();
            if (t + 1 < nt) GS_STG(t + 1, buf ^ 1);
            const LAS unsigned char* sa = lds + buf * 32768; const LAS unsigned char* sb = sa + 16384;
            bf16x8 af[2][4], bq[2][2];
#pragma unroll
            for (int a = 0; a < 2; ++a)
#pragma unroll
                for (int m = 0; m < 4; ++m) af[a][m] = *(const LAS bf16x8*)(sa + (a * 128 + wr * 64 + m * 16 + fr) * 64 + fq * 16);
#pragma unroll
            for (int b = 0; b < 2; ++b)
#pragma unroll
                for (int n = 0; n < 2; ++n) bq[b][n] = *(const LAS bf16x8*)(sb + (b * 128 + wc * 32 + n * 16 + fr) * 64 + fq * 16);
#pragma unroll
            for (int a = 0; a < 2; ++a)
#pragma unroll
                for (int b = 0; b < 2; ++b)
#pragma unroll
                    for (int m = 0; m < 4; ++m)
#pragma unroll
                        for (int n = 0; n < 2; ++n) acc[a][b][m][n] = __builtin_amdgcn_mfma_f32_16x16x32_bf16(bq[b][n], af[a][m], acc[a][b][m][n], 0, 0, 0);
        }
#undef GS_STG
        __syncthreads();
        E(acc, g, wr, wc, fr, fq);
    }
}

constexpr int PG_HTB = 128 * 64 * 2;
__device__ __forceinline__ int pg_lds_byte(int r, int c) { const int st = (r >> 4) * 2 + (c >> 5), rr = r & 15, cc = c & 31, ob = rr * 64 + cc * 2; return st * 1024 + (ob ^ (((ob >> 9) & 1) << 5)); }
__device__ __forceinline__ void pg_stage_rc(int b, int& R, int& C) { const int st = b / 1024, sb = b % 1024, swz = sb ^ (((sb >> 9) & 1) << 5); R = (st >> 1) * 16 + swz / 64; C = (st & 1) * 32 + (swz % 64) / 2; }
__device__ __forceinline__ int pg_order(int L, int nwg) { const int q = nwg / 8, r = nwg % 8, xcd = L % 8, off = L / 8; return (xcd < r ? xcd * (q + 1) : r * (q + 1) + (xcd - r) * q) + off; }

template <class Prov, class Epi, bool ALIGN_EPI, bool SP2>
__device__ __forceinline__ void gemm_phase_pg8(LAS unsigned char* lds, const Prov& PV, const Epi& E, int& tid_m) {
    asm volatile("" : "+v"(tid_m)); const int tid = tid_m;
    __syncthreads();
    if constexpr (Prov::TABLE) {
        const int nun_ = PV.count(); if ((int)blockIdx.x + tid * (int)gridDim.x < nun_ && tid < 256) PV.tab[tid] = PV.tab_val(pg_order(tid * (int)gridDim.x + (int)blockIdx.x, nun_));
        __syncthreads(); }
    const int wid = __builtin_amdgcn_readfirstlane(tid >> 6), lane = tid & 63, wr = wid >> 2, wc = wid & 3, fr = lane & 15, fq = lane >> 4;
    const int nun = PV.count(), G = gridDim.x, c = blockIdx.x;
#define PG8_HAS(i) (Prov::LOCAL ? ((i) < nun) : ((i) * G + c < nun))
#define PG8_UNIT(i) (Prov::LOCAL ? (i) : pg_order((i) * G + c, nun))
    if (!PG8_HAS(0)) return;
    int R_[2], C_[2];
#pragma unroll
    for (int i = 0; i < 2; ++i) pg_stage_rc(tid * 16 + i * 8192, R_[i], C_[i]);
    const unsigned ldsw = (unsigned)wid * 1024u;
    const int aoff = pg_lds_byte(wr * 64 + fr, fq * 8), boff = pg_lds_byte(wc * 32 + fr, fq * 8);
#define PG8_SA(b, h) (((b) * 2 + (h)) * PG_HTB)
#define PG8_SB(b, h) ((4 + (b) * 2 + (h)) * PG_HTB)
#define PG8_STAGE(bufoff, gbase, o0, o1) do { \
        __builtin_amdgcn_global_load_lds((const unsigned*)((const char*)(gbase) + (o0)), (LAS unsigned*)(lds + (bufoff) + ldsw), 16, 0, 0); \
        __builtin_amdgcn_global_load_lds((const unsigned*)((const char*)(gbase) + (o1)), (LAS unsigned*)(lds + (bufoff) + ldsw + 8192), 16, 0, 0); } while (0)
#define PG8_STA(bufoff, gbase, h, NX) do { if constexpr (Prov::GATHER) { PG8_STAGE(bufoff, gbase, (NX) ? nao[h][0] : cao[h][0], (NX) ? nao[h][1] : cao[h][1]); } \
        else { PG8_STAGE(bufoff, (gbase) + (h) * hstepA, vA[0], vA[1]); } } while (0)
#define PG8_STB(bufoff, gbase, h) PG8_STAGE(bufoff, (gbase) + (h) * hstepB, vB[0], vB[1])
#define PG8_LDA(dst, b, h) do { _Pragma("unroll") for (int m = 0; m < 4; ++m) _Pragma("unroll") for (int k = 0; k < 2; ++k) dst[m][k] = *(const LAS v4i*)(lds + PG8_SA(b, h) + aoff + m * 2048 + k * 1024); } while (0)
#define PG8_LDB(dst, b, h) do { _Pragma("unroll") for (int n = 0; n < 2; ++n) _Pragma("unroll") for (int k = 0; k < 2; ++k) dst[n][k] = *(const LAS v4i*)(lds + PG8_SB(b, h) + boff + n * 2048 + k * 1024); } while (0)
#define PG8_MMA(ai, bj, At, Bt) do { __builtin_amdgcn_s_setprio(1); _Pragma("unroll") for (int m = 0; m < 4; ++m) _Pragma("unroll") for (int n = 0; n < 2; ++n) _Pragma("unroll") for (int k = 0; k < 2; ++k) \
        acc[ai][bj][m][n] = __builtin_amdgcn_mfma_f32_16x16x32_bf16(__builtin_bit_cast(bf16x8, Bt[n][k]), __builtin_bit_cast(bf16x8, At[m][k]), acc[ai][bj][m][n], 0, 0, 0); __builtin_amdgcn_s_setprio(0); } while (0)
#define PG8_MMA8(ai, bj, At, Bt) do { __builtin_amdgcn_s_setprio(1); _Pragma("unroll") for (int m = 0; m < 4; ++m) _Pragma("unroll") for (int n = 0; n < 2; ++n) { \
        const v8i bw_ = __builtin_shufflevector(Bt[n][0], Bt[n][1], 0, 1, 2, 3, 4, 5, 6, 7), aw_ = __builtin_shufflevector(At[m][0], At[m][1], 0, 1, 2, 3, 4, 5, 6, 7); \
        asm volatile("s_nop 1\n\tv_mfma_scale_f32_16x16x128_f8f6f4 %0, %1, %2, %0, %3, %4 op_sel_hi:[0,0,0]" : "+v"(acc[ai][bj][m][n]) : "v"(bw_), "v"(aw_), "v"(fp8_scale_w), "v"(fp8_scale_a)); } \
        __builtin_amdgcn_s_setprio(0); } while (0)
#define PG8_MM(ai, bj, At, Bt) do { if constexpr (Prov::FP8) PG8_MMA8(ai, bj, At, Bt); else PG8_MMA(ai, bj, At, Bt); } while (0)
#define PG8_WAIT_V(n) asm volatile("s_waitcnt vmcnt(" #n ")" ::: "memory")
#define PG8_WAIT_L(n) asm volatile("s_waitcnt lgkmcnt(" #n ")" ::: "memory")
#define PG8_BAR __builtin_amdgcn_s_barrier()
#define PG8_SCHED __builtin_amdgcn_sched_barrier(0)
#define PG8_OFFS(g, AO) do { _Pragma("unroll") for (int h = 0; h < 2; ++h) _Pragma("unroll") for (int i = 0; i < 2; ++i) \
        AO[h][i] = (unsigned)(g).gat[h * 128 + R_[i]] * (unsigned)(lda * 2) + (unsigned)(C_[i] * 2); } while (0)
    GUnit cur, nxt; int ui = 0;
    PV.get(PG8_UNIT(0), cur, 0);
    f32x4 acc[2][2][4][2];
#pragma unroll
    for (int a = 0; a < 2; ++a)
#pragma unroll
        for (int b = 0; b < 2; ++b)
#pragma unroll
            for (int m = 0; m < 4; ++m)
#pragma unroll
                for (int n = 0; n < 2; ++n) acc[a][b][m][n] = (f32x4){0.f, 0.f, 0.f, 0.f};
    v4i At[4][2], B0[2][2], B1[2][2];
    const int fp8_scale_w = 0x01010101 * (127 - FP8_W_SHIFT), fp8_scale_a = 0x01010101 * (127 - FP8_A_SHIFT);
    unsigned cao[2][2], nao[2][2], vA[2], vB[2];
    const int lda = PV.lda_(), ldb = PV.ldb_();
    const size_t hstepA = (size_t)128 * lda * 2, hstepB = (size_t)128 * ldb * 2;
#pragma unroll
    for (int i = 0; i < 2; ++i) { vA[i] = (unsigned)(R_[i] * lda + C_[i]) * 2u; vB[i] = (unsigned)(pg_perm_row(R_[i]) * ldb + C_[i]) * 2u; }
    if constexpr (Prov::GATHER) PG8_OFFS(cur, cao);
    const char* cA = (const char*)cur.A; const char* cB = (const char*)cur.Bt;
    const size_t kstep = 128;
    if constexpr (SP2) {
        PG8_STB(PG8_SB(0, 0), cB, 0); PG8_STB(PG8_SB(0, 1), cB, 1); PG8_STA(PG8_SA(0, 0), cA, 0, false); PG8_STA(PG8_SA(0, 1), cA, 1, false);
        if (wr == 1) PG8_BAR;
        PG8_WAIT_V(2); PG8_BAR;
        PG8_STB(PG8_SB(1, 0), cB + kstep, 0); PG8_STA(PG8_SA(1, 0), cA + kstep, 0, false); PG8_STB(PG8_SB(1, 1), cB + kstep, 1);
        PG8_WAIT_V(6); PG8_BAR;
    } else {
        PG8_STB(PG8_SB(0, 0), cB, 0); PG8_STA(PG8_SA(0, 0), cA, 0, false); PG8_STB(PG8_SB(0, 1), cB, 1); PG8_STA(PG8_SA(0, 1), cA, 1, false);
        if (wr == 1) PG8_BAR;
        PG8_WAIT_V(4); PG8_BAR;
        PG8_STB(PG8_SB(1, 0), cB + kstep, 0); PG8_STA(PG8_SA(1, 0), cA + kstep, 0, false); PG8_STB(PG8_SB(1, 1), cB + kstep, 1);
        PG8_WAIT_V(6); PG8_BAR;
    }
    for (;;) {
        const bool has_next = PG8_HAS(ui + 1);
        if (has_next) { PV.get(PG8_UNIT(ui + 1), nxt, ui + 1); if constexpr (Prov::GATHER) PG8_OFFS(nxt, nao); }
        else if constexpr (Prov::GATHER) {
#pragma unroll
            for (int h = 0; h < 2; ++h)
#pragma unroll
                for (int i = 0; i < 2; ++i) nao[h][i] = cao[h][i]; }
        const char* nA = has_next ? (const char*)nxt.A : cA; const char* nB = has_next ? (const char*)nxt.Bt : cB;
        const int nt = PV.kdim() >> 6;
#pragma unroll 1
        for (int t = 0; t < nt; t += 2) {
            const bool last = (t == nt - 2);
#define PG8_KOFF(t_) (Prov::ATILED ? ((size_t)((t_) >> 2) * 131072 + (size_t)((t_) & 3) * 128) : (size_t)(t_) * kstep)
            const char* a1 = cA + PG8_KOFF(t + 1);
            const char* a2 = last ? nA : cA + PG8_KOFF(t + 2); const char* b2 = last ? nB : cB + (size_t)(t + 2) * kstep;
            const char* a3 = a2 + kstep; const char* b3 = b2 + kstep;
            if constexpr (SP2) {
            PG8_LDB(B0, 0, 0); PG8_LDB(B1, 0, 1); PG8_SCHED; PG8_LDA(At, 0, 0); PG8_STA(PG8_SA(1, 1), a1, 1, false);
            PG8_WAIT_V(8); PG8_WAIT_L(0); PG8_BAR; PG8_MM(0, 0, At, B0); PG8_MM(0, 1, At, B1); PG8_BAR; PG8_SCHED;
            PG8_LDA(At, 0, 1); PG8_STB(PG8_SB(0, 0), b2, 0); PG8_STB(PG8_SB(0, 1), b2, 1); PG8_STA(PG8_SA(0, 0), a2, 0, last);
            PG8_WAIT_V(8); PG8_WAIT_L(0); PG8_BAR; PG8_MM(1, 0, At, B0); PG8_MM(1, 1, At, B1); PG8_BAR; PG8_SCHED;
            PG8_LDB(B0, 1, 0); PG8_LDB(B1, 1, 1); PG8_SCHED; PG8_LDA(At, 1, 0); PG8_STA(PG8_SA(0, 1), a2, 1, last);
            PG8_WAIT_V(8); PG8_WAIT_L(0); PG8_BAR; PG8_MM(0, 0, At, B0); PG8_MM(0, 1, At, B1); PG8_BAR; PG8_SCHED;
            PG8_LDA(At, 1, 1); PG8_STB(PG8_SB(1, 0), b3, 0); PG8_STB(PG8_SB(1, 1), b3, 1); PG8_STA(PG8_SA(1, 0), a3, 0, last);
            PG8_WAIT_V(8); PG8_WAIT_L(0); PG8_BAR; PG8_MM(1, 0, At, B0); PG8_MM(1, 1, At, B1); PG8_BAR; PG8_SCHED;
            } else {
            PG8_LDB(B0, 0, 0); PG8_SCHED; PG8_LDA(At, 0, 0); PG8_STA(PG8_SA(1, 1), a1, 1, false);
            PG8_WAIT_L(8); PG8_BAR; PG8_WAIT_L(0); PG8_MM(0, 0, At, B0); PG8_BAR; PG8_SCHED;
            PG8_LDB(B1, 0, 1); PG8_STB(PG8_SB(0, 0), b2, 0);
            PG8_BAR; PG8_WAIT_L(0); PG8_MM(0, 1, At, B1); PG8_BAR;
            PG8_LDA(At, 0, 1); PG8_STA(PG8_SA(0, 0), a2, 0, last);
            PG8_BAR; PG8_WAIT_L(0); PG8_MM(1, 0, At, B0); PG8_BAR; PG8_SCHED;
            PG8_STB(PG8_SB(0, 1), b2, 1);
            PG8_WAIT_V(6); PG8_BAR; PG8_MM(1, 1, At, B1); PG8_BAR;
            PG8_LDB(B0, 1, 0); PG8_SCHED; PG8_LDA(At, 1, 0); PG8_STA(PG8_SA(0, 1), a2, 1, last);
            PG8_WAIT_L(8); PG8_BAR; PG8_WAIT_L(0); PG8_MM(0, 0, At, B0); PG8_BAR; PG8_SCHED;
            PG8_LDB(B1, 1, 1); PG8_STB(PG8_SB(1, 0), b3, 0);
            PG8_BAR; PG8_WAIT_L(0); PG8_MM(0, 1, At, B1); PG8_BAR;
            PG8_LDA(At, 1, 1); PG8_STA(PG8_SA(1, 0), a3, 0, last);
            PG8_BAR; PG8_WAIT_L(0); PG8_MM(1, 0, At, B0); PG8_BAR; PG8_SCHED;
            PG8_STB(PG8_SB(1, 1), b3, 1);
            PG8_WAIT_V(6); PG8_BAR; PG8_MM(1, 1, At, B1); PG8_BAR;
            }
        }
        if constexpr (Prov::FP8) asm volatile("s_nop 15\n\ts_nop 15" ::: "memory");
        if constexpr (ALIGN_EPI) { if (wr == 0) PG8_BAR; }
        { asm volatile("" : "+v"(tid_m));
          E(acc, cur, wr, wc, tid_m & 15, (tid_m & 63) >> 4); }
        if (!has_next) break;
#pragma unroll
        for (int a = 0; a < 2; ++a)
#pragma unroll
            for (int b = 0; b < 2; ++b)
#pragma unroll
                for (int m = 0; m < 4; ++m)
#pragma unroll
                    for (int n = 0; n < 2; ++n) acc[a][b][m][n] = (f32x4){0.f, 0.f, 0.f, 0.f};
        cur = nxt; cA = nA; cB = nB; ++ui;
        if constexpr (Prov::GATHER) {
#pragma unroll
            for (int h = 0; h < 2; ++h)
#pragma unroll
                for (int i = 0; i < 2; ++i) cao[h][i] = nao[h][i]; }
        if constexpr (ALIGN_EPI) { if (wr == 1) PG8_BAR; }
    }
    PG8_WAIT_V(0);
    if constexpr (!ALIGN_EPI) { if (wr == 0) PG8_BAR; }
    PG8_BAR;
#undef PG8_SA
#undef PG8_SB
#undef PG8_STAGE
#undef PG8_STA
#undef PG8_STB
#undef PG8_LDA
#undef PG8_LDB
#undef PG8_MMA
#undef PG8_MMA8
#undef PG8_MM
#undef PG8_WAIT_V
#undef PG8_WAIT_L
#undef PG8_BAR
#undef PG8_SCHED
#undef PG8_OFFS
#undef PG8_KOFF
#undef PG8_HAS
#undef PG8_UNIT
}

#define EPI_FOR_ROWS for (int ai = 0; ai < 2; ++ai) for (int m = 0; m < 4; ++m)
#define EPI_ROW (ai * 128 + wr * 64 + m * 16 + fr)
#define EPI_COL8 (bj * 128 + wc * 32 + 8 * fq)
typedef f32x4 Acc[2][2][4][2];
__device__ __forceinline__ u32x4 pack8(const f32x4 a, const f32x4 b) { u32x4 w; w.x = cvt_pk_bf16(a[0], a[1]); w.y = cvt_pk_bf16(a[2], a[3]); w.z = cvt_pk_bf16(b[0], b[1]); w.w = cvt_pk_bf16(b[2], b[3]); return w; }
__device__ __forceinline__ void unpack8(const u32x4 w, f32x4& a, f32x4& b) { a[0] = lo16(w.x); a[1] = hi16(w.x); a[2] = lo16(w.y); a[3] = hi16(w.y); b[0] = lo16(w.z); b[1] = hi16(w.z); b[2] = lo16(w.w); b[3] = hi16(w.w); }
__device__ __forceinline__ f32x4 sig4(const f32x4 x) { f32x4 r; r[0] = sigmoidf_(x[0]); r[1] = sigmoidf_(x[1]); r[2] = sigmoidf_(x[2]); r[3] = sigmoidf_(x[3]); return r; }
__device__ __forceinline__ f32x4 silu4(const f32x4 x) { f32x4 r; r[0] = siluf_(x[0]); r[1] = siluf_(x[1]); r[2] = siluf_(x[2]); r[3] = siluf_(x[3]); return r; }

struct ProvDense {
    static constexpr bool GATHER = false, LOCAL = false, ATILED = false, TABLE = false, FP8 = false;
    const bf16* A; const bf16* Bt; int lda, K, nM, nN;
    __device__ __forceinline__ int count() const { return nM * nN; }
    __device__ __forceinline__ void get(int u, GUnit& g, int = 0) const { const int nig = 8 * nN, gid = u / nig, fm = gid * 8, gsz = (nM - fm) < 8 ? (nM - fm) : 8, loc = u % nig; g.pm = fm + loc % gsz; g.pn = loc / gsz; g.A = A + (size_t)g.pm * 256 * lda; g.Bt = Bt + (size_t)g.pn * 256 * K; g.gat = nullptr; }
    __device__ __forceinline__ int lda_() const { return lda; }
    __device__ __forceinline__ int ldb_() const { return K; }
    __device__ __forceinline__ int kdim() const { return K; }
};
template <bool PANEL>
struct ProvTiledA {
    static constexpr bool GATHER = false, LOCAL = PANEL, ATILED = true, TABLE = false, FP8 = false;
    const bf16* P; int pn0; const bf16* Bt; int nM, nN;
    __device__ __forceinline__ int count() const { if (PANEL) { const int np = (nM - (int)blockIdx.x + (int)gridDim.x - 1) / (int)gridDim.x; return np * nN; } return nM * nN; }
    __device__ __forceinline__ void get(int u, GUnit& g, int = 0) const {
        if (PANEL) { g.pm = (int)blockIdx.x + (u / nN) * (int)gridDim.x; g.pn = u % nN; }
        else { const int nig = 8 * nN, gid = u / nig, fm = gid * 8, gsz = (nM - fm) < 8 ? (nM - fm) : 8, loc = u % nig; g.pm = fm + loc % gsz; g.pn = loc / gsz; }
        g.A = P + (((size_t)g.pm * NPT + pn0) << 16); g.Bt = Bt + (size_t)g.pn * 256 * 1024; g.gat = nullptr; }
    __device__ __forceinline__ int lda_() const { return 256; }
    __device__ __forceinline__ int ldb_() const { return 1024; }
    __device__ __forceinline__ int kdim() const { return 1024; }
};
struct ProvDense8 {
    static constexpr bool GATHER = false, LOCAL = false, ATILED = false, TABLE = false, FP8 = true;
    const unsigned char* A; const unsigned char* Bt; int K, nM, nN;
    __device__ __forceinline__ int count() const { return nM * nN; }
    __device__ __forceinline__ void get(int u, GUnit& g, int = 0) const { const int nig = 8 * nN, gid = u / nig, fm = gid * 8, gsz = (nM - fm) < 8 ? (nM - fm) : 8, loc = u % nig; g.pm = fm + loc % gsz; g.pn = loc / gsz; g.A = (const bf16*)(A + (size_t)g.pm * 256 * K); g.Bt = (const bf16*)(Bt + (size_t)g.pn * 256 * K); g.gat = nullptr; }
    __device__ __forceinline__ int lda_() const { return K / 2; }
    __device__ __forceinline__ int ldb_() const { return K / 2; }
    __device__ __forceinline__ int kdim() const { return K / 2; }
};
struct ProvPanel {
    static constexpr bool GATHER = false, LOCAL = true, ATILED = false, TABLE = false, FP8 = false;
    const bf16* A; const bf16* Bt; int lda, K, nM, nN;
    __device__ __forceinline__ int count() const { const int np = (nM - (int)blockIdx.x + (int)gridDim.x - 1) / (int)gridDim.x; return np * nN; }
    __device__ __forceinline__ void get(int u, GUnit& g, int = 0) const { g.pm = (int)blockIdx.x + (u / nN) * (int)gridDim.x; g.pn = u % nN; g.A = A + (size_t)g.pm * 256 * lda; g.Bt = Bt + (size_t)g.pn * 256 * K; g.gat = nullptr; }
    __device__ __forceinline__ int lda_() const { return lda; }
    __device__ __forceinline__ int ldb_() const { return K; }
    __device__ __forceinline__ int kdim() const { return K; }
};
constexpr int PG_TAB_OFF = 131072 + 1024;
struct ProvPanel8 {
    static constexpr bool GATHER = false, LOCAL = true, ATILED = false, TABLE = false, FP8 = true;
    const unsigned char* A; const unsigned char* Bt; int K, nM, nN, pa;
    __device__ __forceinline__ int count() const { const int np = (nM - (int)blockIdx.x + (int)gridDim.x - 1) / (int)gridDim.x; return np * nN; }
    __device__ __forceinline__ void get(int u, GUnit& g, int = 0) const { g.pm = (int)blockIdx.x + (u / nN) * (int)gridDim.x; g.pn = u % nN; g.A = (const bf16*)(A + (size_t)g.pm * pa); g.Bt = (const bf16*)(Bt + (size_t)g.pn * 256 * K); g.gat = nullptr; }
    __device__ __forceinline__ int lda_() const { return K / 2; }
    __device__ __forceinline__ int ldb_() const { return K / 2; }
    __device__ __forceinline__ int kdim() const { return K / 2; }
};
struct ProvGateUp {
    static constexpr bool GATHER = true, LOCAL = false, ATILED = false, TABLE = true, FP8 = true;
    const unsigned char* H8; const unsigned char* Wgu; const int* stok; const int* tile_e; int ntiles; LAS int* tab;
    __device__ __forceinline__ int count() const { return ntiles * 2; }
    __device__ __forceinline__ int tab_val(int u) const { return tile_e[u >> 1]; }
    __device__ __forceinline__ void get(int u, GUnit& g, int li) const { g.pm = u >> 1; g.pn = u & 1; const int e = tab[li]; g.A = (const bf16*)H8; g.gat = stok + (size_t)g.pm * 256; g.Bt = (const bf16*)(Wgu + ((size_t)e * 2 + g.pn) * 256 * 1024); }
    __device__ __forceinline__ int lda_() const { return 512; }
    __device__ __forceinline__ int ldb_() const { return 512; }
    __device__ __forceinline__ int kdim() const { return 512; }
};
struct ProvDown {
    static constexpr bool GATHER = false, LOCAL = false, ATILED = false, TABLE = true, FP8 = true;
    const unsigned char* Act; const unsigned char* Wd; const int* tile_e; int ntiles, hf; LAS int* tab;
    __device__ __forceinline__ int count() const { return ntiles * 2; }
    __device__ __forceinline__ int tab_val(int u) const { return tile_e[u >> 1]; }
    __device__ __forceinline__ void get(int u, GUnit& g, int li) const { g.pm = u >> 1; g.pn = 2 * hf + (u & 1); const int e = tab[li]; g.A = (const bf16*)(Act + (size_t)g.pm * 256 * 256); g.gat = nullptr; g.Bt = (const bf16*)(Wd + ((size_t)e * 1024 + g.pn * 256) * 256); }
    __device__ __forceinline__ int lda_() const { return 128; }
    __device__ __forceinline__ int ldb_() const { return 128; }
    __device__ __forceinline__ int kdim() const { return 128; }
};

constexpr int EPI_BB_OFF = 131072 + 2048, EPI_BB_WAVE = 2048;
static_assert(EPI_BB_OFF + 8 * EPI_BB_WAVE <= MISC_OFF, "bounce buffers");
#define EPI_BB(lds_) ((lds_) + EPI_BB_OFF + (wr * 4 + wc) * EPI_BB_WAVE)
#define EPI_LANE (fq * 16 + fr)
__device__ __forceinline__ u32x4 bb_out64(LAS unsigned char* bb, int fr, int fq, u32x4 v) { *(LAS u32x4*)(bb + fr * 64 + fq * 16) = v; return *(const LAS u32x4*)(bb + (fq * 16 + fr) * 16); }
__device__ __forceinline__ u32x4 bb_in64(LAS unsigned char* bb, int fr, int fq, u32x4 v) { *(LAS u32x4*)(bb + (fq * 16 + fr) * 16) = v; return *(const LAS u32x4*)(bb + fr * 64 + fq * 16); }
__device__ __forceinline__ void bb_out128(LAS unsigned char* bb, int fr, int fq, f32x4 a, f32x4 b, f32x4& o0, f32x4& o1) {
    *(LAS f32x4*)(bb + fr * 128 + fq * 32) = a; *(LAS f32x4*)(bb + fr * 128 + fq * 32 + 16) = b; o0 = *(const LAS f32x4*)(bb + (fq * 16 + fr) * 16); o1 = *(const LAS f32x4*)(bb + 1024 + (fq * 16 + fr) * 16); }
__device__ __forceinline__ void bb_in128(LAS unsigned char* bb, int fr, int fq, f32x4 o0, f32x4 o1, f32x4& a, f32x4& b) {
    *(LAS f32x4*)(bb + (fq * 16 + fr) * 16) = o0; *(LAS f32x4*)(bb + 1024 + (fq * 16 + fr) * 16) = o1; a = *(const LAS f32x4*)(bb + fr * 128 + fq * 32); b = *(const LAS f32x4*)(bb + fr * 128 + fq * 32 + 16); }

constexpr float GATE8_SC = 256.0f;
struct EpiInProj { bf16* P; float* GL; LAS unsigned char* lds;
    __device__ __forceinline__ void operator()(const Acc& acc, const GUnit& g, int wr, int wc, int fr, int fq) const {
        LAS unsigned char* bb = EPI_BB(lds); const int l = EPI_LANE;
        if (g.pn >= C_GTA / 256 && g.pn < 28) {
            unsigned char* tile8 = (unsigned char*)P + (((size_t)g.pm * NPT + g.pn) << 17);
#pragma unroll
            EPI_FOR_ROWS { unsigned char* rowp = tile8 + (ai * 128 + wr * 64 + m * 16 + ((l & 31) >> 1)) * 256 + wc * 32 + (l & 1) * 16;
#pragma unroll
                for (int bj = 0; bj < 2; ++bj) { const f32x4 r0 = sig4(acc[ai][bj][m][0]) * GATE8_SC, r1 = sig4(acc[ai][bj][m][1]) * GATE8_SC;
                    u32x2 w; w.x = pk4_fp8(r0[0], r0[1], r0[2], r0[3]); w.y = pk4_fp8(r1[0], r1[1], r1[2], r1[3]);
                    *(LAS u32x2*)(bb + fr * 32 + fq * 8) = w;
                    const u32x4 o = *(const LAS u32x4*)(bb + (l & 31) * 16);
                    if (l < 32) *(u32x4*)(rowp + bj * 128) = o; } }
        } else if (g.pn < 28) {
            const bool ge = (g.pn >= C_GA / 256) && (g.pn < C_Q / 256), si = (g.pn >= C_R / 256) && (g.pn < C_GTA / 256);
#pragma unroll
            EPI_FOR_ROWS { bf16* rowp = P + (((size_t)g.pm * NPT + g.pn) << 16) + (ai * 128 + wr * 64 + m * 16 + (l >> 2)) * 256 + wc * 32 + 8 * (l & 3);
#pragma unroll
                for (int bj = 0; bj < 2; ++bj) { f32x4 v0 = acc[ai][bj][m][0], v1 = acc[ai][bj][m][1];
                    if (ge) { v0[0] = gelu_tanh(v0[0]); v0[1] = gelu_tanh(v0[1]); v0[2] = gelu_tanh(v0[2]); v0[3] = gelu_tanh(v0[3]); v1[0] = gelu_tanh(v1[0]); v1[1] = gelu_tanh(v1[1]); v1[2] = gelu_tanh(v1[2]); v1[3] = gelu_tanh(v1[3]); }
                    if (si) { v0 = silu4(v0); v1 = silu4(v1); }
                    *(u32x4*)(rowp + bj * 128) = bb_out64(bb, fr, fq, pack8(v0, v1)); } }
        } else if (wc == 0 && fq < 2) {
#pragma unroll
            EPI_FOR_ROWS { float* rowp = GL + ((size_t)g.pm * 256 + EPI_ROW) * 16 + 8 * fq; *(f32x4*)rowp = acc[ai][0][m][0]; *(f32x4*)(rowp + 4) = acc[ai][0][m][1]; }
        }
    } };
struct EpiGateMul {
    const bf16* P; int gcol; const unsigned char* base; bf16* out; unsigned char* out8; int opitch; LAS unsigned char* lds;
    __device__ __forceinline__ void operator()(const Acc& acc, const GUnit& g, int wr, int wc, int fr, int fq) const {
        LAS unsigned char* bb = EPI_BB(lds); const int l = EPI_LANE;
        const unsigned char* tile8 = (const unsigned char*)P + (((size_t)g.pm * NPT + (gcol >> 8) + g.pn) << 17);
#pragma unroll
        for (int ai = 0; ai < 2; ++ai)
#pragma unroll
          for (int mh = 0; mh < 2; ++mh) {
            u32x4 gt[2][2], bs[2][2];
#pragma unroll
            for (int m2 = 0; m2 < 2; ++m2)
#pragma unroll
                for (int bj = 0; bj < 2; ++bj) { const int m = 2 * mh + m2; const size_t row = (size_t)g.pm * 256 + ai * 128 + wr * 64 + m * 16 + (l >> 2); const int col = g.pn * 256 + bj * 128 + wc * 32 + 8 * (l & 3);
                    gt[m2][bj] = *(const u32x4*)(tile8 + (ai * 128 + wr * 64 + m * 16 + ((l & 31) >> 1)) * 256 + bj * 128 + wc * 32 + (l & 1) * 16);
                    if (base) bs[m2][bj] = *(const u32x4*)(base + (size_t)g.pm * H8_PANEL + (ai * 128 + wr * 64 + m * 16 + ((l & 31) >> 1)) * 1024 + g.pn * 256 + bj * 128 + wc * 32 + (l & 1) * 16); }
#pragma unroll
            for (int m2 = 0; m2 < 2; ++m2)
#pragma unroll
                for (int bj = 0; bj < 2; ++bj) { const int m = 2 * mh + m2; const size_t row = (size_t)g.pm * 256 + ai * 128 + wr * 64 + m * 16 + (l >> 2); const int col = g.pn * 256 + bj * 128 + wc * 32 + 8 * (l & 3);
                    *(LAS u32x4*)(bb + (l & 31) * 16) = gt[m2][bj]; const u32x2 gw = *(const LAS u32x2*)(bb + fr * 32 + fq * 8);
                    const f32x2_t a0 = __builtin_amdgcn_cvt_pk_f32_fp8((int)gw.x, false), a1 = __builtin_amdgcn_cvt_pk_f32_fp8((int)gw.x, true), a2 = __builtin_amdgcn_cvt_pk_f32_fp8((int)gw.y, false), a3 = __builtin_amdgcn_cvt_pk_f32_fp8((int)gw.y, true);
                    f32x4 r0 = (f32x4){a0.x, a0.y, a1.x, a1.y} * (1.0f / GATE8_SC) * acc[ai][bj][m][0], r1 = (f32x4){a2.x, a2.y, a3.x, a3.y} * (1.0f / GATE8_SC) * acc[ai][bj][m][1];
                    if (base) { *(LAS u32x4*)(bb + (l & 31) * 16) = bs[m2][bj]; const u32x2 bw = *(const LAS u32x2*)(bb + fr * 32 + fq * 8);
                        const f32x2_t c0 = __builtin_amdgcn_cvt_pk_f32_fp8((int)bw.x, false), c1 = __builtin_amdgcn_cvt_pk_f32_fp8((int)bw.x, true), c2 = __builtin_amdgcn_cvt_pk_f32_fp8((int)bw.y, false), c3 = __builtin_amdgcn_cvt_pk_f32_fp8((int)bw.y, true);
                        r0 += (f32x4){c0.x, c0.y, c1.x, c1.y} * (1.0f / (float)(1 << FP8_A_SHIFT)); r1 += (f32x4){c2.x, c2.y, c3.x, c3.y} * (1.0f / (float)(1 << FP8_A_SHIFT)); }
                    if (out8) { constexpr float SC = (float)(1 << FP8_A_SHIFT); u32x2 w8; w8.x = pk4_fp8(r0[0] * SC, r0[1] * SC, r0[2] * SC, r0[3] * SC); w8.y = pk4_fp8(r1[0] * SC, r1[1] * SC, r1[2] * SC, r1[3] * SC);
                        *(LAS u32x2*)(bb + fr * 32 + fq * 8) = w8; const u32x4 o = *(const LAS u32x4*)(bb + (l & 31) * 16);
                        if (l < 32) *(u32x4*)(out8 + (size_t)g.pm * opitch + (ai * 128 + wr * 64 + m * 16 + ((l & 31) >> 1)) * 1024 + g.pn * 256 + bj * 128 + wc * 32 + (l & 1) * 16) = o; }
                    else *(u32x4*)(out + row * 1024 + col) = bb_out64(bb, fr, fq, pack8(r0, r1)); }
          }
    } };
struct EpiHpre { const float* x; bf16* hp; LAS unsigned char* lds;
    __device__ __forceinline__ void operator()(const Acc& acc, const GUnit& g, int wr, int wc, int fr, int fq) const {
        LAS unsigned char* bb = EPI_BB(lds); const int l = EPI_LANE;
#pragma unroll
        for (int ai = 0; ai < 2; ++ai)
#pragma unroll
            for (int mh = 0; mh < 2; ++mh) {
                f32x4 xv[2][2][2];
#pragma unroll
                for (int m2 = 0; m2 < 2; ++m2)
#pragma unroll
                    for (int bj = 0; bj < 2; ++bj) { const float* xp = x + ((size_t)g.pm * 256 + ai * 128 + wr * 64 + (2 * mh + m2) * 16) * 1024 + g.pn * 256 + bj * 128 + wc * 32;
                        xv[m2][bj][0] = *(const f32x4*)(xp + (size_t)(l >> 3) * 1024 + 4 * (l & 7)); xv[m2][bj][1] = *(const f32x4*)(xp + (size_t)(8 + (l >> 3)) * 1024 + 4 * (l & 7)); }
#pragma unroll
                for (int m2 = 0; m2 < 2; ++m2)
#pragma unroll
                    for (int bj = 0; bj < 2; ++bj) { const int m = 2 * mh + m2; f32x4 x0, x1; bb_in128(bb, fr, fq, xv[m2][bj][0], xv[m2][bj][1], x0, x1);
                        *(u32x4*)(hp + ((size_t)g.pm * 256 + ai * 128 + wr * 64 + m * 16 + (l >> 2)) * 1024 + g.pn * 256 + bj * 128 + wc * 32 + 8 * (l & 3)) = bb_out64(bb, fr, fq, pack8(x0 * DN_ALPHA + acc[ai][bj][m][0], x1 * DN_ALPHA + acc[ai][bj][m][1])); }
            }
    } };
struct EpiF32 { float* C; int ldc; LAS unsigned char* lds;
    __device__ __forceinline__ void operator()(const Acc& acc, const GUnit& g, int wr, int wc, int fr, int fq) const {
        LAS unsigned char* bb = EPI_BB(lds); const int l = EPI_LANE;
#pragma unroll
        EPI_FOR_ROWS {
#pragma unroll
            for (int bj = 0; bj < 2; ++bj) { f32x4 o0, o1; bb_out128(bb, fr, fq, acc[ai][bj][m][0], acc[ai][bj][m][1], o0, o1);
                float* cp = C + ((size_t)g.pm * 256 + ai * 128 + wr * 64 + m * 16) * ldc + g.pn * 256 + bj * 128 + wc * 32;
                *(f32x4*)(cp + (size_t)(l >> 3) * ldc + 4 * (l & 7)) = o0; *(f32x4*)(cp + (size_t)(8 + (l >> 3)) * ldc + 4 * (l & 7)) = o1; } }
    } };
struct EpiSwiglu { bf16* out; LAS unsigned char* lds;
    __device__ __forceinline__ void operator()(const Acc& acc, const GUnit& g, int wr, int wc, int fr, int fq) const {
        LAS unsigned char* bb = EPI_BB(lds); const int l = EPI_LANE;
#pragma unroll
        EPI_FOR_ROWS {
            const f32x4 r0 = silu4(acc[ai][0][m][0]) * acc[ai][1][m][0], r1 = silu4(acc[ai][0][m][1]) * acc[ai][1][m][1];
            *(u32x4*)(out + ((size_t)g.pm * 256 + ai * 128 + wr * 64 + m * 16 + (l >> 2)) * 256 + g.pn * 128 + wc * 32 + 8 * (l & 3)) = bb_out64(bb, fr, fq, pack8(r0, r1)); }
    } };
struct EpiShDown { bf16* H; LAS unsigned char* lds;
    __device__ __forceinline__ void operator()(const Acc& acc, const GUnit& g, int wr, int wc, int fr, int fq) const {
        LAS unsigned char* bb = EPI_BB(lds); const int l = EPI_LANE;
#pragma unroll
        for (int ai = 0; ai < 2; ++ai) {
            u32x4 hv[4][2];
#pragma unroll
            for (int m = 0; m < 4; ++m)
#pragma unroll
                for (int bj = 0; bj < 2; ++bj) hv[m][bj] = *(const u32x4*)(H + ((size_t)g.pm * 256 + ai * 128 + wr * 64 + m * 16 + (l >> 2)) * 1024 + g.pn * 256 + bj * 128 + wc * 32 + 8 * (l & 3));
#pragma unroll
            for (int m = 0; m < 4; ++m)
#pragma unroll
                for (int bj = 0; bj < 2; ++bj) { f32x4 h0, h1; unpack8(bb_in64(bb, fr, fq, hv[m][bj]), h0, h1);
                    *(u32x4*)(H + ((size_t)g.pm * 256 + ai * 128 + wr * 64 + m * 16 + (l >> 2)) * 1024 + g.pn * 256 + bj * 128 + wc * 32 + 8 * (l & 3)) = bb_out64(bb, fr, fq, pack8(h0 * DN_ALPHA + acc[ai][bj][m][0], h1 * DN_ALPHA + acc[ai][bj][m][1])); }
        }
    } };
struct EpiSwiglu8 { unsigned char* out; LAS unsigned char* lds;
    __device__ __forceinline__ void operator()(const Acc& acc, const GUnit& g, int wr, int wc, int fr, int fq) const {
        LAS unsigned char* bb = EPI_BB(lds); const int l = EPI_LANE; constexpr float SC = (float)(1 << FP8_A_SHIFT);
#pragma unroll
        EPI_FOR_ROWS { const f32x4 r0 = silu4(acc[ai][0][m][0]) * acc[ai][1][m][0] * SC, r1 = silu4(acc[ai][0][m][1]) * acc[ai][1][m][1] * SC;
            u32x2 w; w.x = pk4_fp8(r0[0], r0[1], r0[2], r0[3]); w.y = pk4_fp8(r1[0], r1[1], r1[2], r1[3]);
            *(LAS u32x2*)(bb + fr * 32 + fq * 8) = w;
            const u32x4 o = *(const LAS u32x4*)(bb + (l & 31) * 16);
            if (l < 32) *(u32x4*)(out + ((size_t)g.pm * 256 + ai * 128 + wr * 64 + m * 16 + (l >> 1)) * 256 + g.pn * 128 + wc * 32 + (l & 1) * 16) = o; }
    } };
struct EpiFp8Tile { unsigned char* out; LAS unsigned char* lds;
    __device__ __forceinline__ void operator()(const Acc& acc, const GUnit& g, int wr, int wc, int fr, int fq) const {
        LAS unsigned char* bb = EPI_BB(lds); const int l = EPI_LANE; constexpr float SC = (float)(1 << FP8_Y_SHIFT);
#pragma unroll
        EPI_FOR_ROWS { unsigned char* rowp = out + ((size_t)g.pm * 256 + ai * 128 + wr * 64 + m * 16 + ((l & 31) >> 1)) * 1024 + g.pn * 256 + wc * 32 + (l & 1) * 16;
#pragma unroll
            for (int bj = 0; bj < 2; ++bj) { const f32x4 r0 = acc[ai][bj][m][0] * SC, r1 = acc[ai][bj][m][1] * SC;
                u32x2 w; w.x = pk4_fp8(r0[0], r0[1], r0[2], r0[3]); w.y = pk4_fp8(r1[0], r1[1], r1[2], r1[3]);
                *(LAS u32x2*)(bb + fr * 32 + fq * 8) = w;
                const u32x4 o = *(const LAS u32x4*)(bb + (l & 31) * 16);
                if (l < 32) *(u32x4*)(rowp + bj * 128) = o; } }
    } };

constexpr int GL_WUP = 0, GL_BG = 8192, GL_NG = 8704, GL_GD = 9728, GL_SS = 10240, GL_RS = 12288, GL_QD = 12800, GL_KI = GL_QD + 17408, GL_KET = GL_KI + 17408, GL_VT = GL_KET + 18432, GL_PM = GL_VT + 36864, GL_BT = GL_PM + 9216;
static_assert(GL_PM + 9216 <= 131072 && 64 * 264 * 2 <= 2 * 17408 && GL_BT + 8 * 64 * 20 * 4 <= MISC_OFF, "GLA LDS");
constexpr int QS = 136, TS = 72, VRS = 264;
typedef short v4i16_t __attribute__((ext_vector_type(4)));
static_assert(64 * VRS * 2 <= 36864, "GLA V image");

__device__ __forceinline__ void gla_unit(Frame& F, int b, int h) {
    PHASE_IDS(F);
    LAS unsigned char* L = F.lds;
    LAS float* WUP = (LAS float*)(L + GL_WUP); LAS float* BG = (LAS float*)(L + GL_BG); LAS float* NG = (LAS float*)(L + GL_NG);
    LAS float* GD = (LAS float*)(L + GL_GD); LAS float* SS = (LAS float*)(L + GL_SS); LAS float* RS = (LAS float*)(L + GL_RS);
    LAS bf16* QD = (LAS bf16*)(L + GL_QD); LAS bf16* KI = (LAS bf16*)(L + GL_KI); LAS bf16* KET = (LAS bf16*)(L + GL_KET); LAS bf16* VT = (LAS bf16*)(L + GL_VT); LAS bf16* PM = (LAS bf16*)(L + GL_PM);
    const int tid = F.tid, lane = F.lane, w = F.wave, fr = lane & 15, fq = lane >> 4;
    bf16* P = WSP(bf16, WS_P); const float* GLW = WSP(float, WS_GL);
    __syncthreads();
    float wB[4], LA[4];
#pragma unroll
    for (int s4 = 0; s4 < 4; ++s4) { wB[s4] = F.in[10][(4 * fq + s4) * 512 + h * 128 + 16 * w + fr]; LA[s4] = (s4 < (fr & 3) || (s4 == (fr & 3) && fq < (fr >> 2))) ? 1.0f : 0.0f; }
    const float biasv = F.in[11][h * 128 + 16 * w + fr];
    if (tid < 256) NG[tid] = F.in[12][h * 256 + tid];
    f32x4 S[8][2];
#pragma unroll
    for (int kt = 0; kt < 8; ++kt) { S[kt][0] = (f32x4){0.f, 0.f, 0.f, 0.f}; S[kt][1] = (f32x4){0.f, 0.f, 0.f, 0.f}; }
    __syncthreads();
    const int dv0 = 32 * w;
    f32x4 gvn[4];
#pragma unroll
    for (int mt = 0; mt < 4; ++mt) gvn[mt] = *(const f32x4*)(GLW + ((size_t)b * SEQ + 16 * mt + fr) * 16 + 4 * fq);
    for (int ch = 0; ch < 32; ++ch) {
        const size_t row0 = (size_t)b * SEQ + 64 * ch;
        const size_t pan = row0 >> 8; const int r0l = (int)(row0 & 255);
        const bf16* tq = P + ((pan * NPT + (C_Q >> 8) + (h >> 1)) << 16) + (h & 1) * 128; const bf16* tk = P + ((pan * NPT + (C_K >> 8) + (h >> 1)) << 16) + (h & 1) * 128;
        const bf16* tv = P + ((pan * NPT + (C_V >> 8) + h) << 16); bf16* tr = P + ((pan * NPT + (C_R >> 8) + h) << 16);
        { float la[16], blv[16];
          u32x4 qv[2], kv[2], vvv[4];
          { const bf16* qp = tq + (r0l + lane) * 256 + 16 * w; qv[0] = *(const u32x4*)qp; qv[1] = *(const u32x4*)(qp + 8); }
          { const bf16* kp = tk + (r0l + lane) * 256 + 16 * w; kv[0] = *(const u32x4*)kp; kv[1] = *(const u32x4*)(kp + 8); }
#pragma unroll
          for (int i = 0; i < 4; ++i) vvv[i] = *(const u32x4*)(tv + (r0l + lane) * 256 + dv0 + 8 * i);
          { f32x4 lg[4], gv[4];
#define MFMA_F32X4(acc_, a_, b_) asm volatile("s_nop 1\n\tv_mfma_f32_16x16x4_f32 %0, %1, %2, %0" : "+v"(acc_) : "v"(a_), "v"(b_))
#define MFMA_F32X4_LAST(acc_, a_, b_) asm volatile("s_nop 1\n\tv_mfma_f32_16x16x4_f32 %0, %1, %2, %0\n\ts_nop 15" : "+v"(acc_) : "v"(a_), "v"(b_))
#define MFMA_F32X4_DEP_LAST(acc_, a_, b_) asm volatile("s_nop 9\n\tv_mfma_f32_16x16x4_f32 %0, %1, %2, %0\n\ts_nop 15" : "+v"(acc_) : "v"(a_), "v"(b_))
#define MFMA_F32X4_DEP(acc_, a_, b_) asm volatile("s_nop 9\n\tv_mfma_f32_16x16x4_f32 %0, %1, %2, %0" : "+v"(acc_) : "v"(a_), "v"(b_))
#pragma unroll
            for (int mt = 0; mt < 4; ++mt) { gv[mt] = gvn[mt]; lg[mt] = (f32x4){biasv, biasv, biasv, biasv}; }
#pragma unroll
            for (int s4 = 0; s4 < 4; ++s4)
#pragma unroll
                for (int mt = 0; mt < 4; ++mt) if (s4 < 3) MFMA_F32X4(lg[mt], gv[mt][s4], wB[s4]);
            asm volatile("s_nop 1\n\tv_mfma_f32_16x16x4_f32 %0, %4, %8, %0\n\tv_mfma_f32_16x16x4_f32 %1, %5, %8, %1\n\tv_mfma_f32_16x16x4_f32 %2, %6, %8, %2\n\tv_mfma_f32_16x16x4_f32 %3, %7, %8, %3\n\ts_nop 15"
                         : "+v"(lg[0]), "+v"(lg[1]), "+v"(lg[2]), "+v"(lg[3]) : "v"(gv[0][3]), "v"(gv[1][3]), "v"(gv[2][3]), "v"(gv[3][3]), "v"(wB[3]));
            if (ch + 1 < 32) {
#pragma unroll
                for (int mt = 0; mt < 4; ++mt) gvn[mt] = *(const f32x4*)(GLW + (row0 + 64 + 16 * mt + fr) * 16 + 4 * fq); }
#pragma unroll
            for (int mt = 0; mt < 4; ++mt) {
#pragma unroll
                for (int r = 0; r < 4; ++r) { const float x = lg[mt][r]; lg[mt][r] = (fminf(x, 0.f) - __builtin_amdgcn_logf(1.0f + __expf(-fabsf(x))) * 0.6931471805599453f) * (1.0f / 16.0f); }
                lg[mt][1] += lg[mt][0]; lg[mt][2] += lg[mt][1]; lg[mt][3] += lg[mt][2]; }
            f32x4 ex = (f32x4){0.f, 0.f, 0.f, 0.f};
#pragma unroll
            for (int kt = 0; kt < 4; ++kt) { if (kt < 3) MFMA_F32X4_DEP(ex, LA[kt], lg[kt][3]); else MFMA_F32X4_DEP_LAST(ex, LA[kt], lg[kt][3]); }
#undef MFMA_F32X4
#undef MFMA_F32X4_DEP
#undef MFMA_F32X4_LAST
#undef MFMA_F32X4_DEP_LAST
            LAS float* BT = (LAS float*)(L + GL_BT) + w * (64 * 20);
#pragma unroll
            for (int mt = 0; mt < 4; ++mt)
#pragma unroll
                for (int r = 0; r < 4; ++r) BT[(16 * mt + 4 * fq + r) * 20 + fr] = lg[mt][r] + ex[mt];
            if (fq == 3) GD[16 * w + fr] = __expf(lg[3][3] + ex[3]);
#pragma unroll
            for (int i = 0; i < 4; ++i) { const f32x4 t = *(const LAS f32x4*)(BT + lane * 20 + 4 * i), u = *(const LAS f32x4*)(GD + 16 * w + 4 * i);
                la[4 * i] = t[0]; la[4 * i + 1] = t[1]; la[4 * i + 2] = t[2]; la[4 * i + 3] = t[3]; blv[4 * i] = u[0]; blv[4 * i + 1] = u[1]; blv[4 * i + 2] = u[2]; blv[4 * i + 3] = u[3]; } }
          unsigned qo[8], ko[8];
#pragma unroll
          for (int j2 = 0; j2 < 8; ++j2) {
              const unsigned qw = qv[j2 >> 2][j2 & 3], kw = kv[j2 >> 2][j2 & 3];
              const float b0 = la[2 * j2], b1 = la[2 * j2 + 1];
              const float bl0 = blv[2 * j2], bl1 = blv[2 * j2 + 1];
              const float e0 = __builtin_amdgcn_exp2f(fmaf(b0, 1.4426950408889634f, -3.5f)), e1 = __builtin_amdgcn_exp2f(fmaf(b1, 1.4426950408889634f, -3.5f)), i0 = __builtin_amdgcn_exp2f(b0 * -1.4426950408889634f), i1 = __builtin_amdgcn_exp2f(b1 * -1.4426950408889634f);
              qo[j2] = pk2(lo16(qw) * e0, hi16(qw) * e1);
              const float ki0 = lo16(kw) * i0, ki1 = hi16(kw) * i1;
              ko[j2] = pk2(ki0, ki1);
              const float g0 = bl0, g1 = bl1; const float ke0 = ki0 * g0, ke1 = ki1 * g1;
              KET[(16 * w + 2 * j2) * TS + lane] = (bf16)f2bf(ke0); KET[(16 * w + 2 * j2 + 1) * TS + lane] = (bf16)f2bf(ke1);
          }
          *(LAS u32x4*)(QD + lane * QS + 16 * w) = (u32x4){qo[0], qo[1], qo[2], qo[3]}; *(LAS u32x4*)(QD + lane * QS + 16 * w + 8) = (u32x4){qo[4], qo[5], qo[6], qo[7]};
          *(LAS u32x4*)(KI + lane * QS + 16 * w) = (u32x4){ko[0], ko[1], ko[2], ko[3]}; *(LAS u32x4*)(KI + lane * QS + 16 * w + 8) = (u32x4){ko[4], ko[5], ko[6], ko[7]};
#pragma unroll
          for (int i = 0; i < 4; ++i) *(LAS u32x4*)(VT + lane * VRS + dv0 + 8 * i) = vvv[i];
        }
        __syncthreads();
#pragma unroll
        for (int tt = 0; tt < 2; ++tt) { const int tl = 2 * w + tt, it = tl >> 2, jt = tl & 3;
            f32x4 acc = (f32x4){0.f, 0.f, 0.f, 0.f};
            if (jt <= it) {
#pragma unroll
                for (int ks = 0; ks < 4; ++ks) { const bf16x8 a = *(const LAS bf16x8*)(QD + (16 * it + fr) * QS + 32 * ks + 8 * fq); const bf16x8 bb = *(const LAS bf16x8*)(KI + (16 * jt + fr) * QS + 32 * ks + 8 * fq);
                    acc = __builtin_amdgcn_mfma_f32_16x16x32_bf16(a, bb, acc, 0, 0, 0); } }
#pragma unroll
            for (int r = 0; r < 4; ++r) { const int i = 16 * it + 4 * fq + r, j = 16 * jt + fr; PM[i * TS + j] = (j <= i) ? (bf16)f2bf(acc[r]) : (bf16)0; } }
        __syncthreads();
        u32x4 rpre[4];
#pragma unroll
        for (int i = 0; i < 4; ++i) { const int idx = tid + 512 * i, tok = idx >> 5, c = (idx & 31) * 8; rpre[i] = *(const u32x4*)(tr + (r0l + tok) * 256 + c); }
        bf16x8 vb[2][2];
#pragma unroll
        for (int ks = 0; ks < 2; ++ks)
#pragma unroll
            for (int nt = 0; nt < 2; ++nt) {
                const LAS bf16* vp = VT + (32 * ks + 8 * fq + (fr >> 2)) * VRS + dv0 + 16 * nt + 4 * (fr & 3);
                const v4i16_t lo = __builtin_amdgcn_ds_read_tr16_b64_v4i16((LAS v4i16_t*)vp), hi = __builtin_amdgcn_ds_read_tr16_b64_v4i16((LAS v4i16_t*)(vp + 4 * VRS));
                vb[ks][nt] = __builtin_shufflevector(lo, hi, 0, 1, 2, 3, 4, 5, 6, 7); }
        f32x4 o[4][2];
#pragma unroll
        for (int mt = 0; mt < 4; ++mt) { o[mt][0] = (f32x4){0.f, 0.f, 0.f, 0.f}; o[mt][1] = (f32x4){0.f, 0.f, 0.f, 0.f}; }
#pragma unroll
        for (int k4 = 0; k4 < 4; ++k4) {
            bf16x8 sb[2];
#pragma unroll
            for (int nt = 0; nt < 2; ++nt) { const f32x4 s0 = S[2 * k4][nt], s1 = S[2 * k4 + 1][nt]; u32x4 pw; pw.x = pk2(s0[0], s0[1]); pw.y = pk2(s0[2], s0[3]); pw.z = pk2(s1[0], s1[1]); pw.w = pk2(s1[2], s1[3]); sb[nt] = __builtin_bit_cast(bf16x8, pw); }
#pragma unroll
            for (int mt = 0; mt < 4; ++mt) { const u32x2 q0 = *(const LAS u32x2*)(QD + (16 * mt + fr) * QS + 32 * k4 + 4 * fq); const u32x2 q1 = *(const LAS u32x2*)(QD + (16 * mt + fr) * QS + 32 * k4 + 16 + 4 * fq);
                const bf16x8 aq = __builtin_bit_cast(bf16x8, (u32x4){q0.x, q0.y, q1.x, q1.y});
                o[mt][0] = __builtin_amdgcn_mfma_f32_16x16x32_bf16(aq, sb[0], o[mt][0], 0, 0, 0); o[mt][1] = __builtin_amdgcn_mfma_f32_16x16x32_bf16(aq, sb[1], o[mt][1], 0, 0, 0); } }
#pragma unroll
        for (int mt = 0; mt < 4; ++mt)
#pragma unroll
            for (int ks = 0; ks < 2; ++ks) if (ks <= (mt >> 1)) { const bf16x8 ap = *(const LAS bf16x8*)(PM + (16 * mt + fr) * TS + 32 * ks + 8 * fq);
                o[mt][0] = __builtin_amdgcn_mfma_f32_16x16x32_bf16(ap, vb[ks][0], o[mt][0], 0, 0, 0); o[mt][1] = __builtin_amdgcn_mfma_f32_16x16x32_bf16(ap, vb[ks][1], o[mt][1], 0, 0, 0); }
#pragma unroll
        for (int kt = 0; kt < 8; ++kt) { const f32x4 gd = *(const LAS f32x4*)(GD + 16 * kt + 4 * fq);
            S[kt][0] = S[kt][0] * gd; S[kt][1] = S[kt][1] * gd;
#pragma unroll
            for (int ks = 0; ks < 2; ++ks) { const bf16x8 ak = *(const LAS bf16x8*)(KET + (16 * kt + fr) * TS + 32 * ks + 8 * fq);
                S[kt][0] = __builtin_amdgcn_mfma_f32_16x16x32_bf16(ak, vb[ks][0], S[kt][0], 0, 0, 0); S[kt][1] = __builtin_amdgcn_mfma_f32_16x16x32_bf16(ak, vb[ks][1], S[kt][1], 0, 0, 0); } }
        { float ss[16];
#pragma unroll
          for (int mt = 0; mt < 4; ++mt)
#pragma unroll
              for (int r = 0; r < 4; ++r) ss[4 * mt + r] = o[mt][0][r] * o[mt][0][r] + o[mt][1][r] * o[mt][1][r];
#define GLA_RED8(D, o_) asm volatile("s_nop 1\n\tv_add_f32_dpp %0, %0, %0 row_shr:" #D " row_mask:0xf bank_mask:0xf\n\tv_add_f32_dpp %1, %1, %1 row_shr:" #D " row_mask:0xf bank_mask:0xf\n\tv_add_f32_dpp %2, %2, %2 row_shr:" #D " row_mask:0xf bank_mask:0xf\n\tv_add_f32_dpp %3, %3, %3 row_shr:" #D " row_mask:0xf bank_mask:0xf\n\t" \
              "v_add_f32_dpp %4, %4, %4 row_shr:" #D " row_mask:0xf bank_mask:0xf\n\tv_add_f32_dpp %5, %5, %5 row_shr:" #D " row_mask:0xf bank_mask:0xf\n\tv_add_f32_dpp %6, %6, %6 row_shr:" #D " row_mask:0xf bank_mask:0xf\n\tv_add_f32_dpp %7, %7, %7 row_shr:" #D " row_mask:0xf bank_mask:0xf" \
              : "+v"(ss[o_]), "+v"(ss[o_ + 1]), "+v"(ss[o_ + 2]), "+v"(ss[o_ + 3]), "+v"(ss[o_ + 4]), "+v"(ss[o_ + 5]), "+v"(ss[o_ + 6]), "+v"(ss[o_ + 7]))
          GLA_RED8(1, 0); GLA_RED8(1, 8); GLA_RED8(2, 0); GLA_RED8(2, 8); GLA_RED8(4, 0); GLA_RED8(4, 8); GLA_RED8(8, 0); GLA_RED8(8, 8);
#undef GLA_RED8
          if (fr == 15) {
#pragma unroll
              for (int mt = 0; mt < 4; ++mt) *(LAS f32x4*)(SS + w * 64 + 16 * mt + 4 * fq) = (f32x4){ss[4 * mt], ss[4 * mt + 1], ss[4 * mt + 2], ss[4 * mt + 3]}; } }
        __syncthreads();
        { LAS bf16* OT = (LAS bf16*)(L + GL_QD);
#pragma unroll
          for (int mt = 0; mt < 4; ++mt)
#pragma unroll
              for (int r = 0; r < 4; ++r) { const int tok = 16 * mt + 4 * fq + r;
#pragma unroll
                  for (int nt = 0; nt < 2; ++nt) { const int dv = dv0 + 16 * nt + fr; OT[tok * 264 + dv] = (bf16)f2bf(o[mt][nt][r] * NG[dv]); } }
          __syncthreads();
#pragma unroll
          for (int i = 0; i < 4; ++i) { const int idx = tid + 512 * i, tok = idx >> 5, c = (idx & 31) * 8;
              const u32x4 ov = *(const LAS u32x4*)(OT + tok * 264 + c); const int po = (r0l + tok) * 256 + c; const u32x4 rv = rpre[i]; u32x4 w;
              float t = 0.f;
#pragma unroll
              for (int ww = 0; ww < 8; ++ww) t += SS[ww * 64 + tok];
              const float rs = __builtin_amdgcn_rsqf(t * (1.0f / 256.0f) + RMS_EPS);
              constexpr float SC = (float)(1 << FP8_A_SHIFT); float f[8];
              const float rsc = rs * SC;
#pragma unroll
              for (int j = 0; j < 4; ++j) { f[2 * j] = (lo16(ov[j]) * lo16(rv[j])) * rsc; f[2 * j + 1] = (hi16(ov[j]) * hi16(rv[j])) * rsc; }
              u32x2 o8; o8.x = pk4_fp8(f[0], f[1], f[2], f[3]); o8.y = pk4_fp8(f[4], f[5], f[6], f[7]); (void)w; (void)po;
              *(u32x2*)((unsigned char*)F.out + pan * H8_PANEL + 262144 + (size_t)(r0l + tok) * 1024 + h * 256 + c) = o8; }
          __syncthreads(); }
    }
}

constexpr int LR_CW = 0, LR_CB = 1024, LR_BA = 1280, LR_BX = 1536, LR_SP = 1792, LR_HC = 2048, LR_AGG = 2304, LR_HIN = 6400, LR_W = 8448, LR_XA = 24832, LR_GA = LR_XA + 259 * 144 + 16  , LR_RS = 144;
static_assert(LR_XA % 16 == 0 && LR_GA % 16 == 0 && LR_GA + 256 * 144 <= 131072, "LRU LDS");

__device__ __forceinline__ void lru_unit(Frame& F, int b, int g) {
    F.lane = F.tid & 63; F.wave = __builtin_amdgcn_readfirstlane(F.tid >> 6);
    LAS unsigned char* L = F.lds;
    LAS float* CW = (LAS float*)(L + LR_CW); LAS float* CB = (LAS float*)(L + LR_CB); LAS float* BA = (LAS float*)(L + LR_BA); LAS float* BX = (LAS float*)(L + LR_BX);
    LAS float* SP = (LAS float*)(L + LR_SP); LAS float* HC = (LAS float*)(L + LR_HC); LAS float* AGG = (LAS float*)(L + LR_AGG); LAS float* HIN = (LAS float*)(L + LR_HIN); LAS bf16* WL = (LAS bf16*)(L + LR_W);
    const int tid = F.tid, lane = F.lane, w = F.wave, fr = lane & 15, fq = lane >> 4;
    bf16* P = WSP(bf16, WS_P);
    __syncthreads();
    if (tid < 256) CW[tid] = F.in[2][(tid >> 6) * 1024 + 64 * g + (tid & 63)];
    if (tid < 64) { const int c = 64 * g + tid; CB[tid] = F.in[3][c]; BA[tid] = F.in[5][c]; BX[tid] = F.in[7][c]; const float lam = F.in[8][c];
        SP[tid] = -1.4426950408889634f * 8.0f * (fmaxf(-lam, 0.f) + log1pf(__expf(-fabsf(lam)))); HC[tid] = 0.f; }
    { const u32x4* src = (const u32x4*)(WSP(bf16, WS_LRUW) + (size_t)g * 2 * 4096); LAS u32x4* dst = (LAS u32x4*)WL; dst[tid] = src[tid]; dst[tid + 512] = src[tid + 512]; }
    __syncthreads();
    LAS unsigned char* XA = L + LR_XA; LAS unsigned char* GA = L + LR_GA;
    u32x4 pfx[5], pfg[4];
#define LRU_PREFETCH(stn) do { int tz_ = tid; asm volatile("" : "+v"(tz_)); const int t0_ = (stn) * 256; const size_t pn_ = ((size_t)b * SEQ + t0_) >> 8; \
        const bf16* txa_ = P + ((pn_ * NPT + (C_XA >> 8) + (g >> 2)) << 16) + (g & 3) * 64; const bf16* tga_ = P + ((pn_ * NPT + (C_GA >> 8) + (g >> 2)) << 16) + (g & 3) * 64; \
        _Pragma("unroll") for (int i = 0; i < 5; ++i) { const int p = tz_ + 512 * i; pfx[i] = (u32x4){0u, 0u, 0u, 0u}; if (p < 259 * 8) { const int r = p >> 3, c16 = p & 7, t = t0_ - 3 + r; \
            if (t >= 0) pfx[i] = *(const u32x4*)(txa_ + (r >= 3 ? (r - 3) * 256 : (r - 3 + 256) * 256 - (NPT << 16)) + 8 * c16); } } \
        _Pragma("unroll") for (int i = 0; i < 4; ++i) { const int p = tz_ + 512 * i, r = p >> 3, c16 = p & 7; pfg[i] = *(const u32x4*)(tga_ + r * 256 + 8 * c16); } } while (0)
    LRU_PREFETCH(0);
    for (int st = 0; st < 8; ++st) {
        const int tb = st * 256 + w * 32, t0 = st * 256;
        __syncthreads();
        int tz = tid; asm volatile("" : "+v"(tz));
        const size_t panl = ((size_t)b * SEQ + t0) >> 8;
        bf16* tga = P + ((panl * NPT + (C_GA >> 8) + (g >> 2)) << 16) + (g & 3) * 64;
#pragma unroll
        for (int i = 0; i < 5; ++i) { const int p = tz + 512 * i; if (p < 259 * 8) { const int r = p >> 3, c16 = p & 7; *(LAS u32x4*)(XA + r * LR_RS + c16 * 16) = pfx[i]; } }
#pragma unroll
        for (int i = 0; i < 4; ++i) { const int p = tz + 512 * i, r = p >> 3, c16 = p & 7; *(LAS u32x4*)(GA + r * LR_RS + c16 * 16) = pfg[i]; }
        __syncthreads();
        if (st + 1 < 8) LRU_PREFETCH(st + 1);
        float Aa[2][16], Uu[2][16];
#pragma unroll
        for (int mt = 0; mt < 2; ++mt) {
            float xc[2][8];
#pragma unroll
            for (int ks = 0; ks < 2; ++ks) {
                const int c0 = 32 * ks + 8 * fq;
                { const f32x4 b0 = *(const LAS f32x4*)(CB + c0), b1 = *(const LAS f32x4*)(CB + c0 + 4);
                  xc[ks][0] = b0[0]; xc[ks][1] = b0[1]; xc[ks][2] = b0[2]; xc[ks][3] = b0[3]; xc[ks][4] = b1[0]; xc[ks][5] = b1[1]; xc[ks][6] = b1[2]; xc[ks][7] = b1[3]; }
#pragma unroll
                for (int tap = 0; tap < 4; ++tap) {
                    const u32x4 xv = *(const LAS u32x4*)(XA + (w * 32 + 16 * mt + fr + tap) * LR_RS + c0 * 2);
                    const f32x4 w0 = *(const LAS f32x4*)(CW + tap * 64 + c0), w1 = *(const LAS f32x4*)(CW + tap * 64 + c0 + 4);
                    xc[ks][0] += w0[0] * lo16(xv.x); xc[ks][1] += w0[1] * hi16(xv.x); xc[ks][2] += w0[2] * lo16(xv.y); xc[ks][3] += w0[3] * hi16(xv.y);
                    xc[ks][4] += w1[0] * lo16(xv.z); xc[ks][5] += w1[1] * hi16(xv.z); xc[ks][6] += w1[2] * lo16(xv.w); xc[ks][7] += w1[3] * hi16(xv.w);
                }
            }
            bf16x8 xf[2];
#pragma unroll
            for (int ks = 0; ks < 2; ++ks) { u32x4 pw; pw.x = pk2(xc[ks][0], xc[ks][1]); pw.y = pk2(xc[ks][2], xc[ks][3]); pw.z = pk2(xc[ks][4], xc[ks][5]); pw.w = pk2(xc[ks][6], xc[ks][7]); xf[ks] = __builtin_bit_cast(bf16x8, pw); }
#pragma unroll
            for (int nt = 0; nt < 4; ++nt) {
                const int nact = 32 * (nt >> 1) + 8 * (fr >> 2) + 4 * (nt & 1) + (fr & 3);
                f32x4 ar = (f32x4){0.f, 0.f, 0.f, 0.f}, ax = (f32x4){0.f, 0.f, 0.f, 0.f};
#pragma unroll
                for (int ks = 0; ks < 2; ++ks) { const bf16x8 wa = *(const LAS bf16x8*)(WL + nact * 64 + 32 * ks + 8 * fq); const bf16x8 wx = *(const LAS bf16x8*)(WL + 4096 + nact * 64 + 32 * ks + 8 * fq);
                    ar = __builtin_amdgcn_mfma_f32_16x16x32_bf16(wa, xf[ks], ar, 0, 0, 0); ax = __builtin_amdgcn_mfma_f32_16x16x32_bf16(wx, xf[ks], ax, 0, 0, 0); }
                const int cb = 32 * (nt >> 1) + 8 * fq + 4 * (nt & 1);
                const f32x4 ba = *(const LAS f32x4*)(BA + cb), bx = *(const LAS f32x4*)(BX + cb), sp = *(const LAS f32x4*)(SP + cb);
#pragma unroll
                for (int r = 0; r < 4; ++r) {
                    const float rg = sigmoidf_(ar[r] + ba[r]), ig = sigmoidf_(ax[r] + bx[r]);
                    const float a = __builtin_amdgcn_exp2f(rg * sp[r]);
                    Aa[mt][4 * nt + r] = a; Uu[mt][4 * nt + r] = __builtin_amdgcn_sqrtf(fmaf(-a, a, 1.0f)) * ig * xc[nt >> 1][4 * (nt & 1) + r];
                }
            }
#define LRU_U8(D, o) asm volatile("s_nop 1\n\tv_fmac_f32_dpp %0, %0, %8 row_shr:" #D " row_mask:0xf bank_mask:0xf\n\tv_fmac_f32_dpp %1, %1, %9 row_shr:" #D " row_mask:0xf bank_mask:0xf\n\tv_fmac_f32_dpp %2, %2, %10 row_shr:" #D " row_mask:0xf bank_mask:0xf\n\tv_fmac_f32_dpp %3, %3, %11 row_shr:" #D " row_mask:0xf bank_mask:0xf\n\t" \
                "v_fmac_f32_dpp %4, %4, %12 row_shr:" #D " row_mask:0xf bank_mask:0xf\n\tv_fmac_f32_dpp %5, %5, %13 row_shr:" #D " row_mask:0xf bank_mask:0xf\n\tv_fmac_f32_dpp %6, %6, %14 row_shr:" #D " row_mask:0xf bank_mask:0xf\n\tv_fmac_f32_dpp %7, %7, %15 row_shr:" #D " row_mask:0xf bank_mask:0xf" \
                : "+v"(Uu[mt][o]), "+v"(Uu[mt][o + 1]), "+v"(Uu[mt][o + 2]), "+v"(Uu[mt][o + 3]), "+v"(Uu[mt][o + 4]), "+v"(Uu[mt][o + 5]), "+v"(Uu[mt][o + 6]), "+v"(Uu[mt][o + 7]) \
                : "v"(Aa[mt][o]), "v"(Aa[mt][o + 1]), "v"(Aa[mt][o + 2]), "v"(Aa[mt][o + 3]), "v"(Aa[mt][o + 4]), "v"(Aa[mt][o + 5]), "v"(Aa[mt][o + 6]), "v"(Aa[mt][o + 7]))
#define LRU_A8(D, o) asm volatile("s_nop 1\n\tv_mul_f32_dpp %0, %0, %0 row_shr:" #D " row_mask:0xf bank_mask:0xf\n\tv_mul_f32_dpp %1, %1, %1 row_shr:" #D " row_mask:0xf bank_mask:0xf\n\tv_mul_f32_dpp %2, %2, %2 row_shr:" #D " row_mask:0xf bank_mask:0xf\n\tv_mul_f32_dpp %3, %3, %3 row_shr:" #D " row_mask:0xf bank_mask:0xf\n\t" \
                "v_mul_f32_dpp %4, %4, %4 row_shr:" #D " row_mask:0xf bank_mask:0xf\n\tv_mul_f32_dpp %5, %5, %5 row_shr:" #D " row_mask:0xf bank_mask:0xf\n\tv_mul_f32_dpp %6, %6, %6 row_shr:" #D " row_mask:0xf bank_mask:0xf\n\tv_mul_f32_dpp %7, %7, %7 row_shr:" #D " row_mask:0xf bank_mask:0xf" \
                : "+v"(Aa[mt][o]), "+v"(Aa[mt][o + 1]), "+v"(Aa[mt][o + 2]), "+v"(Aa[mt][o + 3]), "+v"(Aa[mt][o + 4]), "+v"(Aa[mt][o + 5]), "+v"(Aa[mt][o + 6]), "+v"(Aa[mt][o + 7]))
#define LRU_STEP(D) do { LRU_U8(D, 0); LRU_U8(D, 8); LRU_A8(D, 0); LRU_A8(D, 8); } while (0)
            LRU_STEP(1); LRU_STEP(2); LRU_STEP(4); LRU_STEP(8);
#undef LRU_U8
#undef LRU_A8
#undef LRU_STEP
            asm volatile("s_nop 1" ::: "memory");
            asm volatile("" ::: "memory");
        }
#pragma unroll
        for (int e = 0; e < 16; ++e) { const float a0 = lane_read(Aa[0][e], lane | 15), u0 = lane_read(Uu[0][e], lane | 15);
            Uu[1][e] = Aa[1][e] * u0 + Uu[1][e]; Aa[1][e] = Aa[1][e] * a0; }
        if (fr == 15) {
#pragma unroll
            for (int e = 0; e < 16; ++e) { const int c = 32 * (e >> 3) + 8 * fq + (e & 7); *(LAS f32x2_t*)(AGG + (w * 64 + c) * 2) = (f32x2_t){Aa[1][e], Uu[1][e]}; } }
        __syncthreads();
        if (w == 0) { float hc = HC[lane];
#pragma unroll
            for (int ww = 0; ww < 8; ++ww) { HIN[ww * 64 + lane] = hc; hc = AGG[(ww * 64 + lane) * 2] * hc + AGG[(ww * 64 + lane) * 2 + 1]; }
            HC[lane] = hc; }
        __syncthreads();
        float hin[16];
#pragma unroll
        for (int e = 0; e < 16; ++e) hin[e] = HIN[w * 64 + 32 * (e >> 3) + 8 * fq + (e & 7)];
#pragma unroll
        for (int mt = 0; mt < 2; ++mt) {
            LAS unsigned char* grow = GA + (w * 32 + 16 * mt + fr) * LR_RS;
            u32x4 gv[2];
#pragma unroll
            for (int ks = 0; ks < 2; ++ks) gv[ks] = *(const LAS u32x4*)(grow + (32 * ks + 8 * fq) * 2);
#pragma unroll
            for (int ks = 0; ks < 2; ++ks) { float hv[8];
#pragma unroll
                for (int j2 = 0; j2 < 4; ++j2) { const int e0 = 8 * ks + 2 * j2;
                    const float h0 = Uu[mt][e0] + Aa[mt][e0] * hin[e0], h1 = Uu[mt][e0 + 1] + Aa[mt][e0 + 1] * hin[e0 + 1];
                    hv[2 * j2] = h0 * lo16(gv[ks][j2]) * (float)(1 << FP8_A_SHIFT); hv[2 * j2 + 1] = h1 * hi16(gv[ks][j2]) * (float)(1 << FP8_A_SHIFT); }
                u32x2 o8; o8.x = pk4_fp8(hv[0], hv[1], hv[2], hv[3]); o8.y = pk4_fp8(hv[4], hv[5], hv[6], hv[7]);
                *(LAS u32x2*)(grow + 32 * ks + 8 * fq) = o8; }
        }
        __syncthreads();
        asm volatile("" : "+v"(tz));
        { unsigned char* d8 = (unsigned char*)F.out + panl * H8_PANEL + 64 * g;
#pragma unroll
          for (int i = 0; i < 2; ++i) { const int p = tz + 512 * i, r = p >> 2, c = p & 3; *(u32x4*)(d8 + (size_t)r * 1024 + 16 * c) = *(const LAS u32x4*)(GA + r * LR_RS + 16 * c); } }
    }
}

#undef LRU_PREFETCH
__device__ __forceinline__ void phase_mixers(Frame& F, volatile LAS unsigned* MISC) {
    unsigned* head = (unsigned*)(F.ws + WS_CTL) + CW_MIXQ;
    for (;;) {
        __syncthreads();
        if (F.tid == 0) MISC[16] = __hip_atomic_fetch_add(head, 1u, __ATOMIC_RELAXED, __HIP_MEMORY_SCOPE_AGENT);
        __syncthreads();
        const int u = (int)MISC[16];
        if (u >= 128 + 512) break;
        if (u < 128) gla_unit(F, u >> 2, u & 3); else lru_unit(F, (u - 128) >> 4, (u - 128) & 15);
    }
}

__device__ __forceinline__ float wave_sum(float v) {
#pragma unroll
    for (int o = 1; o < 64; o <<= 1) v += __shfl_xor(v, o);
    return v;
}
__device__ __forceinline__ void ln_row(f32x4 (&v)[4]) {
    float s = 0.f;
#pragma unroll
    for (int j = 0; j < 4; ++j) s += (v[j][0] + v[j][1]) + (v[j][2] + v[j][3]);
    const float mean = wave_sum(s) * (1.f / 1024.f); float s2 = 0.f;
#pragma unroll
    for (int j = 0; j < 4; ++j) { v[j] = v[j] - mean; s2 += (v[j][0] * v[j][0] + v[j][1] * v[j][1]) + (v[j][2] * v[j][2] + v[j][3] * v[j][3]); }
    const float rstd = rsqrtf(wave_sum(s2) * (1.f / 1024.f) + LN_EPS);
#pragma unroll
    for (int j = 0; j < 4; ++j) v[j] = v[j] * rstd;
}
__device__ __forceinline__ void ln1_rows(Frame& F, int row_lo, int nrows) {
    PHASE_IDS(F);
    bf16* H = WSP(bf16, WS_H); unsigned char* H8P = (unsigned char*)F.out; constexpr float SC8 = (float)(1 << FP8_A_SHIFT);
    f32x4 gg[4], bb[4];
#pragma unroll
    for (int j = 0; j < 4; ++j) { gg[j] = *(const f32x4*)(F.in[15] + 8 * F.lane + 512 * (j >> 1) + 4 * (j & 1)); bb[j] = *(const f32x4*)(F.in[16] + 8 * F.lane + 512 * (j >> 1) + 4 * (j & 1)); }
    for (int r0 = row_lo + F.wave * 8; r0 < row_lo + nrows; r0 += 64) { u32x4 raw[8][2];
#pragma unroll
        for (int i = 0; i < 8; ++i)
#pragma unroll
            for (int j2 = 0; j2 < 2; ++j2) raw[i][j2] = *(const u32x4*)(H + (size_t)(r0 + i) * 1024 + 8 * F.lane + 512 * j2);
#pragma unroll
        for (int i = 0; i < 8; ++i) { f32x4 v[4]; unpack8(raw[i][0], v[0], v[1]); unpack8(raw[i][1], v[2], v[3]);
            ln_row(v);
#pragma unroll
            for (int j2 = 0; j2 < 2; ++j2) { const f32x4 o0 = v[2 * j2] * gg[2 * j2] + bb[2 * j2], o1 = v[2 * j2 + 1] * gg[2 * j2 + 1] + bb[2 * j2 + 1];
                *(u32x4*)(H + (size_t)(r0 + i) * 1024 + 8 * F.lane + 512 * j2) = pack8(o0, o1);
                u32x2 q; q.x = pk4_fp8(o0[0] * SC8, o0[1] * SC8, o0[2] * SC8, o0[3] * SC8); q.y = pk4_fp8(o1[0] * SC8, o1[1] * SC8, o1[2] * SC8, o1[3] * SC8);
                *(u32x2*)(H8P + (size_t)((r0 + i) >> 8) * H8_PANEL + ((r0 + i) & 255) * 1024 + 8 * F.lane + 512 * j2) = q; } } }
}
__device__ __forceinline__ void phase_combine(Frame& F) {
    PHASE_IDS(F);
    constexpr int NT = 2;
    const int gw = blockIdx.x * 8 + F.wave, NGW = gridDim.x * 8; const unsigned char* Y = WSP(unsigned char, WS_Y8); const int* ts = WSP(int, WS_TSLOT); const float* wt = WSP(float, WS_WT); const bf16* HR = WSP(bf16, WS_H);
    f32x4 gg[4], bb[4];
#pragma unroll
    for (int j = 0; j < 4; ++j) { gg[j] = *(const f32x4*)(F.in[25] + 16 * F.lane + 4 * j); bb[j] = *(const f32x4*)(F.in[26] + 16 * F.lane + 4 * j); }
    u32x4 s0n[NT], s1n[NT]; f32x4 w0n[NT], w1n[NT];
#pragma unroll
    for (int i = 0; i < NT; ++i) { const size_t t = (size_t)(gw * NT + i); s0n[i] = *(const u32x4*)(ts + t * 8); s1n[i] = *(const u32x4*)(ts + t * 8 + 4); w0n[i] = *(const f32x4*)(wt + t * 8); w1n[i] = *(const f32x4*)(wt + t * 8 + 4); }
    for (int t0 = gw * NT; t0 < T; t0 += NGW * NT) {
        u32x4 s0[NT], s1[NT]; f32x4 w0[NT], w1[NT];
#pragma unroll
        for (int i = 0; i < NT; ++i) { s0[i] = s0n[i]; s1[i] = s1n[i]; w0[i] = w0n[i]; w1[i] = w1n[i]; }
        if (t0 + NGW * NT < T) {
#pragma unroll
            for (int i = 0; i < NT; ++i) { const size_t t = (size_t)(t0 + NGW * NT + i); s0n[i] = *(const u32x4*)(ts + t * 8); s1n[i] = *(const u32x4*)(ts + t * 8 + 4); w0n[i] = *(const f32x4*)(wt + t * 8); w1n[i] = *(const f32x4*)(wt + t * 8 + 4); } }
        u32x4 y[NT][8];
#pragma unroll
        for (int i = 0; i < NT; ++i) {
#pragma unroll
            for (int k = 0; k < 8; ++k) { const unsigned sl = k < 4 ? s0[i][k & 3] : s1[i][k & 3]; y[i][k] = *(const u32x4*)(Y + (size_t)sl * 1024 + 16 * F.lane); } }
        f32x4 v[NT][4];
#pragma unroll
        for (int i = 0; i < NT; ++i) { const u32x4 r0 = *(const u32x4*)(HR + (size_t)(t0 + i) * 1024 + 16 * F.lane), r1 = *(const u32x4*)(HR + (size_t)(t0 + i) * 1024 + 16 * F.lane + 8);
            unpack8(r0, v[i][0], v[i][1]); unpack8(r1, v[i][2], v[i][3]); }
#pragma unroll
        for (int i = 0; i < NT; ++i) {
#pragma unroll
            for (int k = 0; k < 8; ++k) { const float w = (k < 4 ? w0[i][k & 3] : w1[i][k & 3]) * (1.0f / (float)(1 << FP8_Y_SHIFT));
#pragma unroll
                for (int j = 0; j < 4; ++j) { const f32x2_t lo = __builtin_amdgcn_cvt_pk_f32_fp8((int)y[i][k][j], false), hi = __builtin_amdgcn_cvt_pk_f32_fp8((int)y[i][k][j], true);
                    v[i][j][0] += w * lo.x; v[i][j][1] += w * lo.y; v[i][j][2] += w * hi.x; v[i][j][3] += w * hi.y; } }
            ln_row(v[i]);
#pragma unroll
            for (int j = 0; j < 4; ++j) *(f32x4*)(F.out + (size_t)(t0 + i) * 1024 + 16 * F.lane + 4 * j) = v[i][j] * gg[j] + bb[j]; }
    }
}

__device__ __forceinline__ void phase_h_to_fp8(Frame& F) {
    PHASE_IDS(F);
    constexpr float SC = (float)(1 << FP8_A_SHIFT);
    for (int pm = blockIdx.x; pm < T / 256; pm += gridDim.x) {
        const u32x4* H = WSP(u32x4, WS_H) + (size_t)pm * 256 * 128; u32x2* H8 = WSP(u32x2, WS_H8) + (size_t)pm * 256 * 128;
        for (int i = F.tid; i < 256 * 128; i += 4 * 512) { u32x4 v[4];
#pragma unroll
            for (int j = 0; j < 4; ++j) v[j] = H[i + j * 512];
#pragma unroll
            for (int j = 0; j < 4; ++j) { f32x4 a, b; unpack8(v[j], a, b); u32x2 o; o.x = pk4_fp8(a[0] * SC, a[1] * SC, a[2] * SC, a[3] * SC); o.y = pk4_fp8(b[0] * SC, b[1] * SC, b[2] * SC, b[3] * SC); H8[i + j * 512] = o; } }
    }
    asm volatile("s_waitcnt vmcnt(0)" ::: "memory"); __syncthreads();
}

constexpr int RT_HIST = 0, RT_GS = 1024, RT_RB = 5120, RT_LG = 6144, RT_STRIDE = 257;
static_assert(RT_LG + 128 * RT_STRIDE * 4 <= MISC_OFF, "routing LDS");
__device__ __forceinline__ void route_block(Frame& F, int tb) {
    LAS int* hist = (LAS int*)(F.lds + RT_HIST); LAS float* GS = (LAS float*)(F.lds + RT_GS); LAS float* LS = (LAS float*)(F.lds + RT_LG);
    const float* LG = WSP(float, WS_LG); const float* rb = F.in[18];
    int* IDX = WSP(int, WS_IDX); float* WT = WSP(float, WS_WT); int* RANK = WSP(int, WS_RANK); int* CNT = WSP(int, WS_CNT);
    __syncthreads();
    LAS float* RB = (LAS float*)(F.lds + RT_RB);
    if (F.tid < 256) { hist[F.tid] = 0; RB[F.tid] = rb[F.tid]; }
    const f32x4 rbv = *(const f32x4*)(rb + (F.tid & 63) * 4);
    for (int half = 0; half < 2; ++half) {
        __syncthreads();
        { const f32x4* src = (const f32x4*)(LG + ((size_t)tb * 256 + half * 128) * 256);
          f32x4 lv[16];
#pragma unroll
          for (int i = 0; i < 16; ++i) lv[i] = src[F.tid + 512 * i];
#pragma unroll
          for (int i = 0; i < 16; ++i) { const int q = F.tid + 512 * i; const f32x4 v = lv[i]; const int r = q >> 6, c = (q & 63) * 4; LAS float* d = LS + r * RT_STRIDE + c;
              d[0] = sigmoidf_(v[0]) + rbv[0]; d[1] = sigmoidf_(v[1]) + rbv[1]; d[2] = sigmoidf_(v[2]) + rbv[2]; d[3] = sigmoidf_(v[3]) + rbv[3]; } }
        __syncthreads();
        { const int tok = F.tid >> 2, part = F.tid & 3; LAS float* lg = LS + tok * RT_STRIDE;
#pragma unroll
          for (int gg = 0; gg < 2; ++gg) { const int g = 2 * part + gg; float m1 = -INFINITY, m2 = -INFINITY;
#pragma unroll 8
              for (int i = 0; i < 32; ++i) { const float v = lg[32 * g + ((i + 8 * part) & 31)]; if (v > m1) { m2 = m1; m1 = v; } else if (v > m2) m2 = v; }
              GS[tok * 8 + g] = m1 + m2; } }
        __syncthreads();
        if (F.tid < 128) {
            const int t = tb * 256 + half * 128 + F.tid; LAS float* lg = LS + F.tid * RT_STRIDE;
            float gs[8];
            { const f32x4 g0 = *(const LAS f32x4*)(GS + F.tid * 8), g1 = *(const LAS f32x4*)(GS + F.tid * 8 + 4); gs[0] = g0[0]; gs[1] = g0[1]; gs[2] = g0[2]; gs[3] = g0[3]; gs[4] = g1[0]; gs[5] = g1[1]; gs[6] = g1[2]; gs[7] = g1[3]; }
            unsigned gmask = 0u;
#pragma unroll
            for (int p = 0; p < 4; ++p) { float best = -INFINITY; int bi = 0;
#pragma unroll
                for (int g = 0; g < 8; ++g) { const bool ok = !((gmask >> g) & 1u) && gs[g] > best; best = ok ? gs[g] : best; bi = ok ? g : bi; }
                gmask |= 1u << bi; }
            float tv[8]; int ti[8];
#pragma unroll
            for (int k = 0; k < 8; ++k) { tv[k] = -INFINITY; ti[k] = 0; }
            for (int g = 0; g < 8; ++g) { if (!((gmask >> g) & 1u)) continue;
                for (int i = 0; i < 32; ++i) { const int e = 32 * g + i; float v = lg[e]; int id = e;
                    if (v > tv[7]) {
#pragma unroll
                        for (int k = 0; k < 8; ++k) { const bool sw = v > tv[k]; const float tvk = tv[k]; const int tik = ti[k]; tv[k] = sw ? v : tvk; ti[k] = sw ? id : tik; v = sw ? tvk : v; id = sw ? tik : id; } } } }
            float sc[8], ssum = 0.f;
#pragma unroll
            for (int k = 0; k < 8; ++k) { sc[k] = tv[k] - RB[ti[k]]; ssum += sc[k]; }
            const float inv = 2.5f / ssum;
#pragma unroll
            for (int k = 0; k < 8; ++k) { IDX[(size_t)t * 8 + k] = ti[k]; WT[(size_t)t * 8 + k] = sc[k] * inv; RANK[(size_t)t * 8 + k] = __hip_atomic_fetch_add(&hist[ti[k]], 1, __ATOMIC_RELAXED, __HIP_MEMORY_SCOPE_WORKGROUP); }
        }
    }
    __syncthreads();
    if (F.tid < 256) CNT[tb * 256 + F.tid] = hist[F.tid];
}
__device__ __forceinline__ void phase_route_own(Frame& F) {
    PHASE_IDS(F);
    asm volatile("s_waitcnt vmcnt(0)" ::: "memory"); __syncthreads();
    for (int pm = blockIdx.x; pm < T / 256; pm += gridDim.x) route_block(F, pm);
}
__device__ __forceinline__ void phase_slots(Frame& F) {
    PHASE_IDS(F);
    LAS int* base = (LAS int*)F.lds; LAS int* pad = base + 256; LAS int* tot = base + 512; LAS int* pst = base + 768; LAS int* part = base + 1280;
    const int* IDX = WSP(int, WS_IDX); const int* RANK = WSP(int, WS_RANK); const int* CNT = WSP(int, WS_CNT);
    int* TSLOT = WSP(int, WS_TSLOT); int* STOK = WSP(int, WS_STOK); int* TILE = WSP(int, WS_TILE);
    for (int tb = blockIdx.x; tb < T / 256; tb += gridDim.x) {
        __syncthreads();
        { const int e = F.tid & 255, hh = F.tid >> 8; int run = 0, mine = 0; const int* c = CNT + (size_t)hh * 128 * 256 + e;
#pragma unroll 16
          for (int j = 0; j < 128; ++j) { const int v = c[j * 256]; run += v; mine += (hh * 128 + j < tb) ? v : 0; }
          if (hh) { part[2 * e] = run; part[2 * e + 1] = mine; }
          __syncthreads();
          if (!hh) { run += part[2 * e]; mine += part[2 * e + 1]; base[e] = mine; tot[e] = run; pad[e] = (run + 255) & ~255; } }
        __syncthreads();
        if (F.tid < 64) { const int p0 = pad[4 * F.tid], p1 = pad[4 * F.tid + 1], p2 = pad[4 * F.tid + 2], p3 = pad[4 * F.tid + 3]; const int sl = p0 + p1 + p2 + p3;
            const int incl = (int)wave_incl_scan((float)sl), ex = incl - sl;
            pst[4 * F.tid] = ex; pst[4 * F.tid + 1] = ex + p0; pst[4 * F.tid + 2] = ex + p0 + p1; pst[4 * F.tid + 3] = ex + p0 + p1 + p2; if (F.tid == 63) pst[256] = incl; }
        __syncthreads();
        if (F.tid < 256) {
            const int t = tb * 256 + F.tid;
            const u32x4 i0 = *(const u32x4*)(IDX + (size_t)t * 8), i1 = *(const u32x4*)(IDX + (size_t)t * 8 + 4), r0 = *(const u32x4*)(RANK + (size_t)t * 8), r1 = *(const u32x4*)(RANK + (size_t)t * 8 + 4);
            u32x4 s0, s1;
#pragma unroll
            for (int k = 0; k < 4; ++k) { s0[k] = (unsigned)(pst[i0[k]] + base[i0[k]]) + r0[k]; s1[k] = (unsigned)(pst[i1[k]] + base[i1[k]]) + r1[k]; }
            *(u32x4*)(TSLOT + (size_t)t * 8) = s0; *(u32x4*)(TSLOT + (size_t)t * 8 + 4) = s1;
            const int rowidx = (t >> 8) * 512 + (t & 255);
#pragma unroll
            for (int k = 0; k < 4; ++k) { STOK[s0[k]] = rowidx; STOK[s1[k]] = rowidx; }
            if (F.tid == 0) { const int e = tb; for (int sp = pst[e] + tot[e]; sp < pst[e] + pad[e]; ++sp) STOK[sp] = 0;
                for (int tl = pst[e] >> 8; tl < (pst[e] + pad[e]) >> 8; ++tl) TILE[tl] = e;
                if (e == 0) TILE[4096] = pst[256] >> 8; }
        }
    }
}

#if GEMM_FAST
#define GEMM_PHASE(lds_, pv_, ep_) gemm_phase_pg8<decltype(pv_), decltype(ep_), PG_ALIGN, PG_SP2>(lds_, pv_, ep_, F.tid)
#define GEMM_PHASE_NA(lds_, pv_, ep_) gemm_phase_pg8<decltype(pv_), decltype(ep_), false, PG_SP2>(lds_, pv_, ep_, F.tid)
#else
#define GEMM_PHASE(lds_, pv_, ep_) gemm_phase_simple(lds_, pv_, ep_, F.tid)
#define GEMM_PHASE_NA(lds_, pv_, ep_) gemm_phase_simple(lds_, pv_, ep_, F.tid)
#endif
enum { PH_PRO = 0, PH_INPROJ, PH_MIX, PH_MERGE, PH_MID, PH_SLOTS, PH_GU, PH_DOWN, PH_COMB, PH_COUNT };

template <int LO, int HI>
__global__ void __launch_bounds__(512, 2) mega(const Params prm) {
    extern __shared__ __attribute__((aligned(16))) unsigned char lds_raw[];
    Frame F;
    F.lds = (LAS unsigned char*)lds_raw; F.tid = threadIdx.x; F.lane = F.tid & 63; F.wave = __builtin_amdgcn_readfirstlane(F.tid >> 6);
    F.in = prm.in; F.out = prm.out; F.ws = prm.ws;
    volatile LAS unsigned* MISC = (volatile LAS unsigned*)(F.lds + MISC_OFF);
    constexpr bool MULTI = (HI - LO > 1);
    XcdBarrier bar; bar.bar = (unsigned*)(F.ws + WS_CTL) + CW_BAR; bar.x = 0; bar.st = MISC + 8;
    if (F.tid < 32) MISC[F.tid] = 0u;
    __syncthreads();
    if constexpr (MULTI) bar = xcd_barrier_post((unsigned*)(F.ws + WS_CTL) + CW_BAR, MISC + 8, F.tid);
#define IN(k) (LO <= (k) && (k) < HI)
#define SEAM(k) do { if constexpr (IN(k) && IN((k) + 1)) xcd_barrier(bar, F.tid); } while (0)

    if constexpr (IN(PH_PRO)) { for (int rep_ = 0; rep_ < (PROBE_PHASE == PH_PRO ? 2 : 1); ++rep_) { if (rep_) xcd_barrier(bar, F.tid); phase_prologue(F); } } SEAM(PH_PRO);
#if INPROJ_FP8
    if constexpr (IN(PH_INPROJ)) { ProvDense8 pv{(const unsigned char*)F.out + (size_t)T * 2048, WSP(unsigned char, WS_WIN), 1024, 256, 29}; EpiInProj ep{WSP(bf16, WS_P), WSP(float, WS_GL), F.lds}; GEMM_PHASE(F.lds, pv, ep); } SEAM(PH_INPROJ);
#else
    if constexpr (IN(PH_INPROJ)) { for (int rep_ = 0; rep_ < (PROBE_PHASE == PH_INPROJ ? 2 : 1); ++rep_) { if (rep_) xcd_barrier(bar, F.tid); ProvDense pv{(const bf16*)F.out, WSP(bf16, WS_WIN), 1024, 1024, 256, 29}; EpiInProj ep{WSP(bf16, WS_P), WSP(float, WS_GL), F.lds}; GEMM_PHASE(F.lds, pv, ep); } } SEAM(PH_INPROJ);
#endif
    if constexpr (IN(PH_MIX)) { phase_mixers(F, MISC); } SEAM(PH_MIX);
    if constexpr (IN(PH_MERGE)) {
        { ProvPanel8 pv{(const unsigned char*)F.out, WSP(unsigned char, WS_WA), 1024, 256, 4, H8_PANEL}; EpiGateMul ep{WSP(bf16, WS_P), C_GTA, nullptr, nullptr, WSP(unsigned char, WS_H), H8_PANEL, F.lds}; GEMM_PHASE(F.lds, pv, ep); }
        asm volatile("s_waitcnt vmcnt(0)" ::: "memory"); __syncthreads();
        { ProvPanel8 pv{(const unsigned char*)F.out + 262144, WSP(unsigned char, WS_WB), 1024, 256, 4, H8_PANEL}; EpiGateMul ep{WSP(bf16, WS_P), C_GTB, WSP(unsigned char, WS_H), nullptr, (unsigned char*)F.out + (size_t)T * 2048, 256 * 1024, F.lds}; GEMM_PHASE(F.lds, pv, ep); }
        asm volatile("s_waitcnt vmcnt(0)" ::: "memory"); __syncthreads();
        { ProvPanel8 pv{(const unsigned char*)F.out + (size_t)T * 2048, WSP(unsigned char, WS_WO), 1024, 256, 4, 256 * 1024}; EpiHpre ep{F.in[0], WSP(bf16, WS_H), F.lds}; GEMM_PHASE(F.lds, pv, ep); }
        asm volatile("s_waitcnt vmcnt(0)" ::: "memory"); __syncthreads();
        for (int pm = blockIdx.x; pm < T / 256; pm += gridDim.x) ln1_rows(F, pm * 256, 256);
    } SEAM(PH_MERGE);
    if constexpr (IN(PH_MID)) for (int rep_ = 0; rep_ < (PROBE_PHASE == PH_MID ? 2 : 1); ++rep_) {
        if (rep_) xcd_barrier(bar, F.tid);
        const bool conv_first = (blockIdx.x & 1) != 0;
        if (conv_first) phase_expert_convert(F);
        { ProvPanel pv{WSP(bf16, WS_H), WSP(bf16, WS_WR), 1024, 1024, 256, 1}; EpiF32 ep{WSP(float, WS_LG), 256, F.lds}; GEMM_PHASE(F.lds, pv, ep); phase_route_own(F); }
        { ProvPanel8 pv{(const unsigned char*)F.out, WSP(unsigned char, WS_WSGU), 1024, 256, 2, H8_PANEL}; EpiSwiglu8 ep{WSP(unsigned char, WS_ACTSH), F.lds}; GEMM_PHASE(F.lds, pv, ep); }
        asm volatile("s_waitcnt vmcnt(0)" ::: "memory"); __syncthreads();
        { ProvPanel8 pv{WSP(unsigned char, WS_ACTSH), WSP(unsigned char, WS_WSD), 256, 256, 4, 256 * 256}; EpiShDown ep{WSP(bf16, WS_H), F.lds}; GEMM_PHASE(F.lds, pv, ep); }
        if (!conv_first) phase_expert_convert(F);
    } SEAM(PH_MID);
    if constexpr (IN(PH_SLOTS)) { for (int rep_ = 0; rep_ < (PROBE_PHASE == PH_SLOTS ? 2 : 1); ++rep_) { if (rep_) xcd_barrier(bar, F.tid); phase_slots(F); } } SEAM(PH_SLOTS);
    if constexpr (IN(PH_GU)) { for (int rep_ = 0; rep_ < (PROBE_PHASE == PH_GU ? 2 : 1); ++rep_) { if (rep_) xcd_barrier(bar, F.tid); const int ntl = __builtin_amdgcn_readfirstlane(WSP(int, WS_TILE)[4096]); ProvGateUp pv{(const unsigned char*)F.out, WSP(unsigned char, WS_WGU8), WSP(int, WS_STOK), WSP(int, WS_TILE), ntl, (LAS int*)(F.lds + PG_TAB_OFF)}; EpiSwiglu8 ep{WSP(unsigned char, WS_ACT8), F.lds}; GEMM_PHASE(F.lds, pv, ep); } } SEAM(PH_GU);
    if constexpr (IN(PH_DOWN)) { const int ntl = __builtin_amdgcn_readfirstlane(WSP(int, WS_TILE)[4096]);
        { ProvDown pv{WSP(unsigned char, WS_ACT8), WSP(unsigned char, WS_WD8), WSP(int, WS_TILE), ntl, 0, (LAS int*)(F.lds + PG_TAB_OFF)}; EpiFp8Tile ep{WSP(unsigned char, WS_Y8), F.lds}; GEMM_PHASE(F.lds, pv, ep); }
        { ProvDown pv{WSP(unsigned char, WS_ACT8), WSP(unsigned char, WS_WD8), WSP(int, WS_TILE), ntl, 1, (LAS int*)(F.lds + PG_TAB_OFF)}; EpiFp8Tile ep{WSP(unsigned char, WS_Y8), F.lds}; GEMM_PHASE(F.lds, pv, ep); } } SEAM(PH_DOWN);
    if constexpr (IN(PH_COMB)) { phase_combine(F); }
#undef IN
#undef SEAM
}
}

extern "C" void kernel_launch(void* const* d_in, const int* in_sizes, int n_in, void* d_out, int out_size, void* d_ws, size_t ws_size, hipStream_t stream) {
    static int grid = 0;
    if (grid == 0) {
        if (n_in != 27 || in_sizes[0] != T * D || out_size != T * D || ws_size < WS_END) { fprintf(stderr, "kernel_launch: unexpected problem (n_in %d, in0 %d, out %d, ws %zu < %zu); nothing launched\n", n_in, n_in > 0 ? in_sizes[0] : -1, out_size, ws_size, (size_t)WS_END); grid = -1; return; }
        int dev = 0, cus = 0;
        if (hipGetDevice(&dev) != hipSuccess || hipDeviceGetAttribute(&cus, hipDeviceAttributeMultiprocessorCount, dev) != hipSuccess) { grid = -1; return; }
        grid = cus;
    }
    if (grid < 0) return;
    (void)hipMemsetAsync((char*)d_ws + WS_CTL, 0, CTL_BYTES, stream);
    Params p{};
    for (int i = 0; i < 27; ++i) p.in[i] = (const float*)d_in[i];
    p.out = (float*)d_out; p.ws = (unsigned char*)d_ws; p.q_lo = 0; p.q_hi = 2;
#define LAUNCH(LO_, HI_) do { static bool attr_ = false; if (!attr_) { (void)hipFuncSetAttribute((const void*)mega<LO_, HI_>, hipFuncAttributeMaxDynamicSharedMemorySize, LDS_BYTES); attr_ = true; } \
        hipLaunchKernelGGL((mega<LO_, HI_>), dim3(grid), dim3(512), LDS_BYTES, stream, p); } while (0)
#if MK_N_LAUNCHES == 1
    LAUNCH(0, PH_COUNT);
#else
    LAUNCH(0, 1); LAUNCH(1, 2); LAUNCH(2, 3); LAUNCH(3, 4); LAUNCH(4, 5); LAUNCH(5, 6); LAUNCH(6, 7);
    LAUNCH(7, 8); LAUNCH(8, 9);
#endif
}
```

```cpp
#include <hip/hip_runtime.h>
#include <cstdio>
#include <cstdint>

#ifndef GEMM_FAST
#define GEMM_FAST 1
#endif
#ifndef PG_SP2
#define PG_SP2 true
#endif
#ifndef PG_ALIGN
#define PG_ALIGN true
#endif
#ifndef PROBE_PHASE
#define PROBE_PHASE -1
#endif
#ifndef INPROJ_FP8
#define INPROJ_FP8 1
#endif
#ifndef MK_N_LAUNCHES
#define MK_N_LAUNCHES 1
#endif

namespace {
#define LAS __attribute__((address_space(3)))
typedef unsigned short bf16;
typedef short bf16x8 __attribute__((ext_vector_type(8)));
typedef float f32x4 __attribute__((ext_vector_type(4)));
typedef unsigned u32x4 __attribute__((ext_vector_type(4)));
typedef unsigned u32x2 __attribute__((ext_vector_type(2)));
typedef int v4i __attribute__((ext_vector_type(4)));
typedef int v8i __attribute__((ext_vector_type(8)));

constexpr int T = 65536, D = 1024, SEQ = 2048;
constexpr int NPT = 28;
constexpr int C_XA = 0, C_GA = 1024, C_Q = 2048, C_K = 2560, C_V = 3072, C_R = 4096, C_GTA = 5120, C_GTB = 6144;
constexpr int NIN = 7424;
constexpr int DIN = 7184;
constexpr int NE = 256, TOPK = 8, DE = 256;
constexpr int SMAX = T * TOPK + NE * 256;
constexpr float DN_ALPHA = 1.189207115002721f;
constexpr float LN_EPS = 1e-5f, RMS_EPS = 1e-6f;

constexpr size_t MiB = 1u << 20;
constexpr size_t WS_CTL = 0, CTL_BYTES = 1 * MiB;
constexpr size_t WS_WIN = 1 * MiB;
constexpr size_t WS_WA = 16 * MiB, WS_WB = 18 * MiB, WS_WO = 20 * MiB;
constexpr size_t WS_WR = 22 * MiB;
constexpr size_t WS_WSGU = WS_WR + MiB / 2;
constexpr size_t WS_WSD = WS_WSGU + MiB;
constexpr size_t WS_LRUW = 24 * MiB;
constexpr size_t WS_GL = 25 * MiB;
constexpr size_t WS_H = 29 * MiB;
constexpr size_t WS_P = 157 * MiB;
constexpr size_t WS_END = WS_P + (size_t)896 * MiB;
constexpr size_t WS_WD8 = WS_P;
constexpr size_t WS_ACT8 = WS_P + 64 * MiB;
constexpr size_t WS_IDX = WS_P + 208 * MiB;
constexpr size_t WS_WT = WS_IDX + 2 * MiB;
constexpr size_t WS_RANK = WS_WT + 2 * MiB;
constexpr size_t WS_TSLOT = WS_RANK + 2 * MiB;
constexpr size_t WS_STOK = WS_TSLOT + 2 * MiB;
constexpr size_t WS_CNT = WS_STOK + 3 * MiB;
constexpr size_t WS_TILE = WS_CNT + 1 * MiB;
constexpr size_t WS_Y8 = WS_P + 320 * MiB;
constexpr size_t WS_WGU8 = WS_P + 320 * MiB;
constexpr int H8_PANEL = 256 * 2048;
constexpr size_t WS_H8 = WS_P + 224 * MiB;
constexpr size_t WS_LG = WS_P + 576 * MiB;
constexpr size_t WS_ACTSH = WS_P + 640 * MiB;
static_assert(WS_TILE + MiB <= WS_H8 && WS_H8 + 64 * MiB <= WS_Y8 && WS_Y8 + (size_t)SMAX * 1024 <= WS_END && WS_ACTSH + 32 * MiB <= WS_END, "MoE overlay map");
constexpr int FP8_Y_SHIFT = 5;
constexpr int FP8_W_SHIFT = 6, FP8_A_SHIFT = 3;

constexpr int CW_BAR = 4096, CW_MIXQ = 64;

constexpr int LDS_BYTES = 163840;
constexpr int MISC_OFF = LDS_BYTES - 256;

__device__ __forceinline__ size_t pt_off(size_t row, int col) { return (((row >> 8) * NPT + (size_t)(col >> 8)) << 16) + ((row & 255) << 8) + (size_t)(col & 255); }
__device__ __forceinline__ float bf2f(unsigned b) { return __uint_as_float(b << 16); }
typedef float f32x2_t __attribute__((ext_vector_type(2)));
typedef __bf16 bf16x2_t __attribute__((ext_vector_type(2)));
__device__ __forceinline__ unsigned cvt_pk_bf16(float lo, float hi) { const f32x2_t v = {lo, hi}; const bf16x2_t b = __builtin_convertvector(v, bf16x2_t); return __builtin_bit_cast(unsigned, b); }
__device__ __forceinline__ unsigned pk2(float lo, float hi) { return cvt_pk_bf16(lo, hi); }
__device__ __forceinline__ unsigned f2bf(float f) { return cvt_pk_bf16(f, f) & 0xffffu; }
__device__ __forceinline__ float lo16(unsigned w) { return __uint_as_float(w << 16); }
__device__ __forceinline__ float hi16(unsigned w) { return __uint_as_float(w & 0xffff0000u); }
__device__ __forceinline__ float sigmoidf_(float x) { return __builtin_amdgcn_rcpf(1.0f + __expf(-x)); }
__device__ __forceinline__ float siluf_(float x) { return x * sigmoidf_(x); }
__device__ __forceinline__ float gelu_tanh(float x) { return x * sigmoidf_(1.5957691216057308f * (x + 0.044715f * x * x * x)); }

__device__ __forceinline__ float lane_read(float v, int src_lane) { return __int_as_float(__builtin_amdgcn_ds_bpermute(src_lane << 2, __float_as_int(v))); }
template <int N> __device__ __forceinline__ float dpp_row_shr(float v, float oob) { return __int_as_float(__builtin_amdgcn_update_dpp(__float_as_int(oob), __float_as_int(v), 0x110 + N, 0xF, 0xF, false)); }
__device__ __forceinline__ float wave_incl_scan(float v) {
    v += dpp_row_shr<1>(v, 0.f); v += dpp_row_shr<2>(v, 0.f); v += dpp_row_shr<4>(v, 0.f); v += dpp_row_shr<8>(v, 0.f);
    v += __int_as_float(__builtin_amdgcn_update_dpp(0, __float_as_int(v), 0x142, 0xA, 0xF, false));
    v += __int_as_float(__builtin_amdgcn_update_dpp(0, __float_as_int(v), 0x143, 0xC, 0xF, false));
    return v;
}
#define XB_TMO      128
#define XB_XCNT(j)  (256  + 64 * (j))
#define XB_XSUB(j)  (1280 + 64 * (j))
#define XB_XGEN(j)  (2304 + 64 * (j))
#define XB_TOP      3328
#define XB_TOPGEN   3392
#define XCD_BAR_WORDS 3456
#define XB_SPIN_CAP (1u << 18)
__device__ __forceinline__ unsigned xb_ld(unsigned* p)              { return __hip_atomic_load(p, __ATOMIC_RELAXED, __HIP_MEMORY_SCOPE_AGENT); }
__device__ __forceinline__ unsigned xb_add(unsigned* p, unsigned v) { return __hip_atomic_fetch_add(p, v, __ATOMIC_RELAXED, __HIP_MEMORY_SCOPE_AGENT); }
__device__ __forceinline__ unsigned xb_xcc_id() { return (unsigned)__builtin_amdgcn_s_getreg((3 << 11) | 20) & 0xFu; }
#define XB_SPIN(cond, bar) do { unsigned _sp = 0; while (cond) { __builtin_amdgcn_s_sleep(1); \
    if ((++_sp & 255u) == 0u) { if (xb_ld(&(bar)[XB_TMO])) break; if (_sp > XB_SPIN_CAP) { atomicAdd(&(bar)[XB_TMO], 1u); break; } } } } while (0)
struct XcdBarrier { unsigned* bar; unsigned x; volatile LAS unsigned* st; };
__device__ __forceinline__ XcdBarrier xcd_barrier_post(unsigned* bar, volatile LAS unsigned* st, int tid) {
    XcdBarrier b; b.bar = bar; b.x = xb_xcc_id(); b.st = st;
    if (tid == 0) (void)xb_add(&bar[XB_XCNT(b.x)], 1u);
    return b;
}
__device__ __forceinline__ void xcd_barrier_complete(unsigned* bar, unsigned x, unsigned& nloc, unsigned& nx) {
    const unsigned G = gridDim.x * gridDim.y * gridDim.z;
    unsigned sum, cnt, mine, sp = 0u;
    for (;;) {
        sum = 0u; cnt = 0u; mine = 0u;
#pragma unroll
        for (unsigned j = 0; j < 16; ++j) { const unsigned c = xb_ld(&bar[XB_XCNT(j)]); sum += c; cnt += (c > 0u) ? 1u : 0u; mine = (j == x) ? c : mine; }
        if (sum == G) break;
        __builtin_amdgcn_s_sleep(1);
        if ((++sp & 255u) == 0u) { if (xb_ld(&bar[XB_TMO])) break; if (sp > XB_SPIN_CAP) { atomicAdd(&bar[XB_TMO], 1u); break; } }
    }
    nloc = mine > 0u ? mine : 1u; nx = cnt > 0u ? cnt : 1u;
}
__device__ __forceinline__ void xcd_barrier(const XcdBarrier& b, int tid) {
    asm volatile("s_waitcnt vmcnt(0)" ::: "memory");
    __syncthreads();
    if (tid == 0) {
        unsigned* bar = b.bar;
        __builtin_amdgcn_s_waitcnt(0);
        unsigned nloc = b.st[0], nx = b.st[1];
        if (nloc == 0u) { xcd_barrier_complete(bar, b.x, nloc, nx); b.st[0] = nloc; b.st[1] = nx; }
        const unsigned old = xb_add(&bar[XB_XSUB(b.x)], 1u);
        const unsigned gen = old / nloc;
        if (old + 1u == (gen + 1u) * nloc) {
            __builtin_amdgcn_fence(__ATOMIC_RELEASE, "agent");
            asm volatile("s_waitcnt vmcnt(0)" ::: "memory");
            const unsigned og = xb_add(&bar[XB_TOP], 1u);
            const unsigned tg = og / nx;
            if (og + 1u == (tg + 1u) * nx) xb_add(&bar[XB_TOPGEN], 1u);
            else XB_SPIN(xb_ld(&bar[XB_TOPGEN]) == tg, bar);
            __builtin_amdgcn_fence(__ATOMIC_ACQUIRE, "agent");
            xb_add(&bar[XB_XGEN(b.x)], 1u);
            asm volatile("s_waitcnt vmcnt(0)" ::: "memory");
        } else {
            XB_SPIN(xb_ld(&bar[XB_XGEN(b.x)]) == gen, bar);
            __builtin_amdgcn_fence(__ATOMIC_ACQUIRE, "agent");
            asm volatile("s_waitcnt vmcnt(0)" ::: "memory");
        }
    }
    __syncthreads();
}

struct Params { const float* in[27]; float* out; unsigned char* ws; int q_lo, q_hi; };

struct Frame {
    LAS unsigned char* lds;
    int tid, lane, wave;
    const float* const* in;
    float* out; unsigned char* ws;
};
#define WSP(T_, off) ((T_*)(F.ws + (off)))
#define PHASE_IDS(F) do { asm volatile("" : "+v"((F).tid)); (F).lane = (F).tid & 63; (F).wave = __builtin_amdgcn_readfirstlane((F).tid >> 6); } while (0)

__device__ __forceinline__ unsigned pk4_fp8(float a, float b, float c, float d) { int w = 0; w = __builtin_amdgcn_cvt_pk_fp8_f32(a, b, w, false); w = __builtin_amdgcn_cvt_pk_fp8_f32(c, d, w, true); return (unsigned)w; }
__device__ __forceinline__ void tr8_load(f32x4 (&v)[16], const float* src, int ld, int k0, int n0, int lane) {
    const int lr = lane >> 4, lc = (lane & 15) * 4;
#pragma unroll
    for (int i = 0; i < 16; ++i) v[i] = __builtin_nontemporal_load((const f32x4*)(src + (size_t)(k0 + 16 * lr + i) * ld + n0 + lc));
}
__device__ __forceinline__ void tr8_store(const f32x4 (&v)[16], int k0, unsigned char* dst, int dstK, int drow0, int lane, float scale) {
    const int lr = lane >> 4, lc = (lane & 15) * 4;
#pragma unroll
    for (int j = 0; j < 4; ++j) { u32x4 o;
#pragma unroll
        for (int q = 0; q < 4; ++q) o[q] = pk4_fp8(v[4 * q][j] * scale, v[4 * q + 1][j] * scale, v[4 * q + 2][j] * scale, v[4 * q + 3][j] * scale);
        *(u32x4*)(dst + (size_t)(drow0 + lc + j) * dstK + k0 + 16 * lr) = o; }
}
__device__ __forceinline__ void tr_item8(const float* src, int ld, int k0, int n0, unsigned char* dst, int dstK, int drow0, LAS unsigned char*  , int lane, float scale) {
    f32x4 v[16]; tr8_load(v, src, ld, k0, n0, lane); tr8_store(v, k0, dst, dstK, drow0, lane, scale);
}

__device__ __forceinline__ void tr_item(const float* src, int ld, int k0, int n0, bf16* dst, int dstK, int drow0, LAS bf16* scr, int lane) {
    const int lr = lane >> 4, lc = (lane & 15) * 4;
    f32x4 v[16];
#pragma unroll
    for (int i = 0; i < 16; ++i) v[i] = *(const f32x4*)(src + (size_t)(k0 + 4 * i + lr) * ld + n0 + lc);
#pragma unroll
    for (int i = 0; i < 16; ++i) { const int k = 4 * i + lr;
        scr[(lc + 0) * 66 + k] = (bf16)f2bf(v[i][0]); scr[(lc + 1) * 66 + k] = (bf16)f2bf(v[i][1]); scr[(lc + 2) * 66 + k] = (bf16)f2bf(v[i][2]); scr[(lc + 3) * 66 + k] = (bf16)f2bf(v[i][3]); }
    asm volatile("s_waitcnt lgkmcnt(0)" ::: "memory");
#pragma unroll
    for (int j = 0; j < 8; ++j) { const int n = 8 * j + (lane >> 3), c = (lane & 7) * 8;
        const LAS unsigned* p = (const LAS unsigned*)(scr + n * 66 + c); u32x4 o; o.x = p[0]; o.y = p[1]; o.z = p[2]; o.w = p[3];
        *(u32x4*)(dst + (size_t)(drow0 + n) * dstK + k0 + c) = o; }
    asm volatile("s_waitcnt lgkmcnt(0)" ::: "memory");
}

__device__ __forceinline__ void phase_prologue(Frame& F) {
    PHASE_IDS(F);
    const int gw = blockIdx.x * 8 + F.wave, NGW = gridDim.x * 8;
    LAS bf16* scr = (LAS bf16*)(F.lds + F.wave * 16384);
    { const f32x4* x4 = (const f32x4*)F.in[0]; u32x4* xb = (u32x4*)F.out;
      const size_t n8 = (size_t)T * D / 8, gt = (size_t)blockIdx.x * 512 + F.tid, GT = (size_t)gridDim.x * 512;
      for (size_t i = gt; i < n8; i += 4 * GT) { f32x4 a[4], b[4];
#pragma unroll
          for (int j = 0; j < 4; ++j) { a[j] = __builtin_nontemporal_load(x4 + 2 * (i + j * GT)); b[j] = __builtin_nontemporal_load(x4 + 2 * (i + j * GT) + 1); }
#pragma unroll
          for (int j = 0; j < 4; ++j) {
#if !INPROJ_FP8
              u32x4 o; o.x = pk2(a[j].x, a[j].y); o.y = pk2(a[j].z, a[j].w); o.z = pk2(b[j].x, b[j].y); o.w = pk2(b[j].z, b[j].w); xb[i + j * GT] = o;
#else
              constexpr float SC = (float)(1 << FP8_A_SHIFT); u32x2 o8; o8.x = pk4_fp8(a[j].x * SC, a[j].y * SC, a[j].z * SC, a[j].w * SC); o8.y = pk4_fp8(b[j].x * SC, b[j].y * SC, b[j].z * SC, b[j].w * SC);
              ((u32x2*)((unsigned char*)F.out + (size_t)T * 2048))[i + j * GT] = o8;
#endif
          } } }
    constexpr int I_IN = 16 * 112, I_SQ = 16 * 16, I_R = 16 * 4, I_SG = 16 * 4, I_SD = 4 * 16;
    constexpr int NITEMS = I_IN + 3 * I_SQ + I_R + 2 * I_SG + I_SD;
    for (int it = gw; it < NITEMS; it += NGW) {
        int r = it;
        if (r < I_IN) { const int kb = r / 112, nb = r % 112; const int n0d = 64 * nb, n0s = n0d + (n0d >= 5120 ? 16 : 0);
#if INPROJ_FP8
            tr_item8(F.in[1], DIN, 64 * kb, n0s, WSP(unsigned char, WS_WIN), 1024, n0d, (LAS unsigned char*)scr, F.lane, (float)(1 << FP8_W_SHIFT)); continue; } r -= I_IN;
#else
            tr_item(F.in[1], DIN, 64 * kb, n0s, WSP(bf16, WS_WIN), 1024, n0d, scr, F.lane); continue; } r -= I_IN;
#endif
        if (r < I_SQ) { tr_item8(F.in[9], 1024, 64 * (r / 16), 64 * (r % 16), WSP(unsigned char, WS_WA), 1024, 64 * (r % 16), (LAS unsigned char*)scr, F.lane, (float)(1 << FP8_W_SHIFT)); continue; } r -= I_SQ;
        if (r < I_SQ) { tr_item8(F.in[13], 1024, 64 * (r / 16), 64 * (r % 16), WSP(unsigned char, WS_WB), 1024, 64 * (r % 16), (LAS unsigned char*)scr, F.lane, (float)(1 << FP8_W_SHIFT)); continue; } r -= I_SQ;
        if (r < I_SQ) { tr_item8(F.in[14], 1024, 64 * (r / 16), 64 * (r % 16), WSP(unsigned char, WS_WO), 1024, 64 * (r % 16), (LAS unsigned char*)scr, F.lane, (float)(1 << FP8_W_SHIFT)); continue; } r -= I_SQ;
        if (r < I_R) { tr_item(F.in[17], 256, 64 * (r / 4), 64 * (r % 4), WSP(bf16, WS_WR), 1024, 64 * (r % 4), scr, F.lane); continue; } r -= I_R;
        if (r < I_SG) { const int nb = r % 4; tr_item8(F.in[22], 256, 64 * (r / 4), 64 * nb, WSP(unsigned char, WS_WSGU), 1024, (nb >> 1) * 256 + (nb & 1) * 64, (LAS unsigned char*)scr, F.lane, (float)(1 << FP8_W_SHIFT)); continue; } r -= I_SG;
        if (r < I_SG) { const int nb = r % 4; tr_item8(F.in[23], 256, 64 * (r / 4), 64 * nb, WSP(unsigned char, WS_WSGU), 1024, (nb >> 1) * 256 + 128 + (nb & 1) * 64, (LAS unsigned char*)scr, F.lane, (float)(1 << FP8_W_SHIFT)); continue; } r -= I_SG;
        tr_item8(F.in[24], 1024, 64 * (r / 16), 64 * (r % 16), WSP(unsigned char, WS_WSD), 256, 64 * (r % 16), (LAS unsigned char*)scr, F.lane, (float)(1 << FP8_W_SHIFT));
    }
    { const size_t gt = (size_t)blockIdx.x * 512 + F.tid, GT = (size_t)gridDim.x * 512; bf16* wi = WSP(bf16, WS_WIN);
      for (size_t i = gt; i < (size_t)256 * 1024; i += GT) { const int rr = (int)(i >> 10), k = (int)(i & 1023);
#if INPROJ_FP8
          ((unsigned char*)wi)[(size_t)(7168 + rr) * 1024 + k] = rr < 16 ? (unsigned char)(pk4_fp8(F.in[1][(size_t)k * DIN + 5120 + rr] * (float)(1 << FP8_W_SHIFT), 0.f, 0.f, 0.f) & 0xffu) : (unsigned char)0; }
#else
          wi[(size_t)(7168 + rr) * 1024 + k] = rr < 16 ? (bf16)f2bf(F.in[1][(size_t)k * DIN + 5120 + rr]) : (bf16)0; }
#endif
      bf16* lw = WSP(bf16, WS_LRUW);
      for (size_t i = gt; i < (size_t)2 * 65536; i += GT) { const int gate = (int)(i >> 16), r2 = (int)(i & 65535), g = r2 >> 12, n = (r2 >> 6) & 63, k = r2 & 63;
          const float* w = gate ? F.in[6] : F.in[4];
          lw[((size_t)(g * 2 + gate) * 64 + n) * 64 + k] = (bf16)f2bf(w[(size_t)g * 4096 + k * 64 + n]); } }
}

struct EconvItem { const float* src; unsigned char* dst; int ld, k0, n0, dstK, drow0; };
__device__ __forceinline__ EconvItem econv_item(Frame& F, int r) {
    constexpr int I_G = 256 * 16 * 4;
    EconvItem it;
    if (r < 2 * I_G) { const int up = r >= I_G; if (up) r -= I_G; const int e = r >> 6, kb = (r >> 2) & 15, nb = r & 3;
        it.src = F.in[up ? 20 : 19] + (size_t)e * 1024 * 256; it.ld = 256; it.k0 = 64 * kb; it.n0 = 64 * nb; it.dst = WSP(unsigned char, WS_WGU8) + (size_t)e * 512 * 1024; it.dstK = 1024; it.drow0 = (nb >> 1) * 256 + up * 128 + (nb & 1) * 64; }
    else { r -= 2 * I_G; const int e = r >> 6, kb = (r >> 4) & 3, nb = r & 15;
        it.src = F.in[21] + (size_t)e * 256 * 1024; it.ld = 1024; it.k0 = 64 * kb; it.n0 = 64 * nb; it.dst = WSP(unsigned char, WS_WD8) + (size_t)e * 1024 * 256; it.dstK = 256; it.drow0 = 64 * nb; }
    return it;
}
__device__ __forceinline__ void phase_expert_convert(Frame& F) {
    PHASE_IDS(F);
    __syncthreads();
    const int gw = blockIdx.x * 8 + F.wave, NGW = gridDim.x * 8;
    constexpr int NIT = 2 * 256 * 16 * 4 + 256 * 4 * 16; constexpr float SC = (float)(1 << FP8_W_SHIFT);
#pragma unroll 1
    for (int r = gw; r < NIT; r += 2 * NGW) {
        const EconvItem ia = econv_item(F, r); f32x4 va[16]; tr8_load(va, ia.src, ia.ld, ia.k0, ia.n0, F.lane);
        if (r + NGW < NIT) { const EconvItem ib = econv_item(F, r + NGW); f32x4 vb[16]; tr8_load(vb, ib.src, ib.ld, ib.k0, ib.n0, F.lane);
            tr8_store(va, ia.k0, ia.dst, ia.dstK, ia.drow0, F.lane, SC); tr8_store(vb, ib.k0, ib.dst, ib.dstK, ib.drow0, F.lane, SC); }
        else tr8_store(va, ia.k0, ia.dst, ia.dstK, ia.drow0, F.lane, SC);
    }
}

__device__ __forceinline__ int pg_perm_row(int r) { const int rho = r & 31, n = rho >> 4, i = rho & 15; return (r & ~31) + 8 * (i >> 2) + 4 * n + (i & 3); }
struct GUnit { const bf16* A; const bf16* Bt; const int* gat; int pm, pn; };

__device__ __forceinline__ void glds16(const void* g, LAS unsigned char* l) { __builtin_amdgcn_global_load_lds((const unsigned*)g, (LAS unsigned*)l, 16, 0, 0); }

template <class Prov, class Epi>
__device__ __forceinline__ void gemm_phase_simple(LAS unsigned char* lds, const Prov& PV, const Epi& E, int& tid_m) {
    asm volatile("" : "+v"(tid_m)); const int tid = tid_m;
    const int wid = __builtin_amdgcn_readfirstlane(tid >> 6), lane = tid & 63;
    const int wr = wid >> 2, wc = wid & 3, fr = lane & 15, fq = lane >> 4;
    static_assert(!Prov::ATILED && !Prov::FP8, "the simple body has no tiled-A / fp8 path");
    const int nun = PV.count();
    for (int i = 0; Prov::LOCAL ? (i < nun) : (i * (int)gridDim.x + (int)blockIdx.x < nun); ++i) {
        static_assert(!Prov::TABLE || true, ""); GUnit g; if constexpr (Prov::TABLE) { __syncthreads(); if (tid == 0) PV.tab[0] = PV.tab_val(i * (int)gridDim.x + (int)blockIdx.x); __syncthreads(); PV.get(i * (int)gridDim.x + (int)blockIdx.x, g, 0); } else PV.get(Prov::LOCAL ? i : i * (int)gridDim.x + (int)blockIdx.x, g);
        const int r0 = tid >> 2, c8 = (tid & 3) * 8;
        long ra0 = r0, ra1 = r0 + 128;
        if (g.gat) { ra0 = g.gat[r0]; ra1 = g.gat[r0 + 128]; }
        const bf16* pa0 = g.A + ra0 * PV.lda_() + c8; const bf16* pa1 = g.A + ra1 * PV.lda_() + c8;
        const bf16* pb0 = g.Bt + (long)pg_perm_row(r0) * PV.ldb_() + c8; const bf16* pb1 = g.Bt + (long)pg_perm_row(r0 + 128) * PV.ldb_() + c8;
        f32x4 acc[2][2][4][2];
#pragma unroll
        for (int a = 0; a < 2; ++a)
#pragma unroll
            for (int b = 0; b < 2; ++b)
#pragma unroll
                for (int m = 0; m < 4; ++m)
#pragma unroll
                    for (int n = 0; n < 2; ++n) acc[a][b][m][n] = (f32x4){0.f, 0.f, 0.f, 0.f};
        const int nt = PV.kdim() >> 5;
#define GS_STG(t, buf) do { LAS unsigned char* d_ = lds + (buf) * 32768 + wid * 1024; \
        glds16(pa0 + (t) * 32, d_); glds16(pa1 + (t) * 32, d_ + 8192); glds16(pb0 + (t) * 32, d_ + 16384); glds16(pb1 + (t) * 32, d_ + 24576); } while (0)
        GS_STG(0, 0);
        for (int t = 0; t < nt; ++t) {
            const int buf = t & 1;
            asm volatile("s_waitcnt vmcnt(0)" ::: "memory"); __syncthreads();
            if (t + 1 < nt) GS_STG(t + 1, buf ^ 1);
            const LAS unsigned char* sa = lds + buf * 32768; const LAS unsigned char* sb = sa + 16384;
            bf16x8 af[2][4], bq[2][2];
#pragma unroll
            for (int a = 0; a < 2; ++a)
#pragma unroll
                for (int m = 0; m < 4; ++m) af[a][m] = *(const LAS bf16x8*)(sa + (a * 128 + wr * 64 + m * 16 + fr) * 64 + fq * 16);
#pragma unroll
            for (int b = 0; b < 2; ++b)
#pragma unroll
                for (int n = 0; n < 2; ++n) bq[b][n] = *(const LAS bf16x8*)(sb + (b * 128 + wc * 32 + n * 16 + fr) * 64 + fq * 16);
#pragma unroll
            for (int a = 0; a < 2; ++a)
#pragma unroll
                for (int b = 0; b < 2; ++b)
#pragma unroll
                    for (int m = 0; m < 4; ++m)
#pragma unroll
                        for (int n = 0; n < 2; ++n) acc[a][b][m][n] = __builtin_amdgcn_mfma_f32_16x16x32_bf16(bq[b][n], af[a][m], acc[a][b][m][n], 0, 0, 0);
        }
#undef GS_STG
        __syncthreads();
        E(acc, g, wr, wc, fr, fq);
    }
}

constexpr int PG_HTB = 128 * 64 * 2;
__device__ __forceinline__ int pg_lds_byte(int r, int c) { const int st = (r >> 4) * 2 + (c >> 5), rr = r & 15, cc = c & 31, ob = rr * 64 + cc * 2; return st * 1024 + (ob ^ (((ob >> 9) & 1) << 5)); }
__device__ __forceinline__ void pg_stage_rc(int b, int& R, int& C) { const int st = b / 1024, sb = b % 1024, swz = sb ^ (((sb >> 9) & 1) << 5); R = (st >> 1) * 16 + swz / 64; C = (st & 1) * 32 + (swz % 64) / 2; }
__device__ __forceinline__ int pg_order(int L, int nwg) { const int q = nwg / 8, r = nwg % 8, xcd = L % 8, off = L / 8; return (xcd < r ? xcd * (q + 1) : r * (q + 1) + (xcd - r) * q) + off; }

template <class Prov, class Epi, bool ALIGN_EPI, bool SP2>
__device__ __forceinline__ void gemm_phase_pg8(LAS unsigned char* lds, const Prov& PV, const Epi& E, int& tid_m) {
    asm volatile("" : "+v"(tid_m)); const int tid = tid_m;
    __syncthreads();
    if constexpr (Prov::TABLE) {
        const int nun_ = PV.count(); if ((int)blockIdx.x + tid * (int)gridDim.x < nun_ && tid < 256) PV.tab[tid] = PV.tab_val(pg_order(tid * (int)gridDim.x + (int)blockIdx.x, nun_));
        __syncthreads(); }
    const int wid = __builtin_amdgcn_readfirstlane(tid >> 6), lane = tid & 63, wr = wid >> 2, wc = wid & 3, fr = lane & 15, fq = lane >> 4;
    const int nun = PV.count(), G = gridDim.x, c = blockIdx.x;
#define PG8_HAS(i) (Prov::LOCAL ? ((i) < nun) : ((i) * G + c < nun))
#define PG8_UNIT(i) (Prov::LOCAL ? (i) : pg_order((i) * G + c, nun))
    if (!PG8_HAS(0)) return;
    int R_[2], C_[2];
#pragma unroll
    for (int i = 0; i < 2; ++i) pg_stage_rc(tid * 16 + i * 8192, R_[i], C_[i]);
    const unsigned ldsw = (unsigned)wid * 1024u;
    const int aoff = pg_lds_byte(wr * 64 + fr, fq * 8), boff = pg_lds_byte(wc * 32 + fr, fq * 8);
#define PG8_SA(b, h) (((b) * 2 + (h)) * PG_HTB)
#define PG8_SB(b, h) ((4 + (b) * 2 + (h)) * PG_HTB)
#define PG8_STAGE(bufoff, gbase, o0, o1) do { \
        __builtin_amdgcn_global_load_lds((const unsigned*)((const char*)(gbase) + (o0)), (LAS unsigned*)(lds + (bufoff) + ldsw), 16, 0, 0); \
        __builtin_amdgcn_global_load_lds((const unsigned*)((const char*)(gbase) + (o1)), (LAS unsigned*)(lds + (bufoff) + ldsw + 8192), 16, 0, 0); } while (0)
#define PG8_STA(bufoff, gbase, h, NX) do { if constexpr (Prov::GATHER) { PG8_STAGE(bufoff, gbase, (NX) ? nao[h][0] : cao[h][0], (NX) ? nao[h][1] : cao[h][1]); } \
        else { PG8_STAGE(bufoff, (gbase) + (h) * hstepA, vA[0], vA[1]); } } while (0)
#define PG8_STB(bufoff, gbase, h) PG8_STAGE(bufoff, (gbase) + (h) * hstepB, vB[0], vB[1])
#define PG8_LDA(dst, b, h) do { _Pragma("unroll") for (int m = 0; m < 4; ++m) _Pragma("unroll") for (int k = 0; k < 2; ++k) dst[m][k] = *(const LAS v4i*)(lds + PG8_SA(b, h) + aoff + m * 2048 + k * 1024); } while (0)
#define PG8_LDB(dst, b, h) do { _Pragma("unroll") for (int n = 0; n < 2; ++n) _Pragma("unroll") for (int k = 0; k < 2; ++k) dst[n][k] = *(const LAS v4i*)(lds + PG8_SB(b, h) + boff + n * 2048 + k * 1024); } while (0)
#define PG8_MMA(ai, bj, At, Bt) do { __builtin_amdgcn_s_setprio(1); _Pragma("unroll") for (int m = 0; m < 4; ++m) _Pragma("unroll") for (int n = 0; n < 2; ++n) _Pragma("unroll") for (int k = 0; k < 2; ++k) \
        acc[ai][bj][m][n] = __builtin_amdgcn_mfma_f32_16x16x32_bf16(__builtin_bit_cast(bf16x8, Bt[n][k]), __builtin_bit_cast(bf16x8, At[m][k]), acc[ai][bj][m][n], 0, 0, 0); __builtin_amdgcn_s_setprio(0); } while (0)
#define PG8_MMA8(ai, bj, At, Bt) do { __builtin_amdgcn_s_setprio(1); _Pragma("unroll") for (int m = 0; m < 4; ++m) _Pragma("unroll") for (int n = 0; n < 2; ++n) { \
        const v8i bw_ = __builtin_shufflevector(Bt[n][0], Bt[n][1], 0, 1, 2, 3, 4, 5, 6, 7), aw_ = __builtin_shufflevector(At[m][0], At[m][1], 0, 1, 2, 3, 4, 5, 6, 7); \
        asm volatile("s_nop 1\n\tv_mfma_scale_f32_16x16x128_f8f6f4 %0, %1, %2, %0, %3, %4 op_sel_hi:[0,0,0]" : "+v"(acc[ai][bj][m][n]) : "v"(bw_), "v"(aw_), "v"(fp8_scale_w), "v"(fp8_scale_a)); } \
        __builtin_amdgcn_s_setprio(0); } while (0)
#define PG8_MM(ai, bj, At, Bt) do { if constexpr (Prov::FP8) PG8_MMA8(ai, bj, At, Bt); else PG8_MMA(ai, bj, At, Bt); } while (0)
#define PG8_WAIT_V(n) asm volatile("s_waitcnt vmcnt(" #n ")" ::: "memory")
#define PG8_WAIT_L(n) asm volatile("s_waitcnt lgkmcnt(" #n ")" ::: "memory")
#define PG8_BAR __builtin_amdgcn_s_barrier()
#define PG8_SCHED __builtin_amdgcn_sched_barrier(0)
#define PG8_OFFS(g, AO) do { _Pragma("unroll") for (int h = 0; h < 2; ++h) _Pragma("unroll") for (int i = 0; i < 2; ++i) \
        AO[h][i] = (unsigned)(g).gat[h * 128 + R_[i]] * (unsigned)(lda * 2) + (unsigned)(C_[i] * 2); } while (0)
    GUnit cur, nxt; int ui = 0;
    PV.get(PG8_UNIT(0), cur, 0);
    f32x4 acc[2][2][4][2];
#pragma unroll
    for (int a = 0; a < 2; ++a)
#pragma unroll
        for (int b = 0; b < 2; ++b)
#pragma unroll
            for (int m = 0; m < 4; ++m)
#pragma unroll
                for (int n = 0; n < 2; ++n) acc[a][b][m][n] = (f32x4){0.f, 0.f, 0.f, 0.f};
    v4i At[4][2], B0[2][2], B1[2][2];
    const int fp8_scale_w = 0x01010101 * (127 - FP8_W_SHIFT), fp8_scale_a = 0x01010101 * (127 - FP8_A_SHIFT);
    unsigned cao[2][2], nao[2][2], vA[2], vB[2];
    const int lda = PV.lda_(), ldb = PV.ldb_();
    const size_t hstepA = (size_t)128 * lda * 2, hstepB = (size_t)128 * ldb * 2;
#pragma unroll
    for (int i = 0; i < 2; ++i) { vA[i] = (unsigned)(R_[i] * lda + C_[i]) * 2u; vB[i] = (unsigned)(pg_perm_row(R_[i]) * ldb + C_[i]) * 2u; }
    if constexpr (Prov::GATHER) PG8_OFFS(cur, cao);
    const char* cA = (const char*)cur.A; const char* cB = (const char*)cur.Bt;
    const size_t kstep = 128;
    if constexpr (SP2) {
        PG8_STB(PG8_SB(0, 0), cB, 0); PG8_STB(PG8_SB(0, 1), cB, 1); PG8_STA(PG8_SA(0, 0), cA, 0, false); PG8_STA(PG8_SA(0, 1), cA, 1, false);
        if (wr == 1) PG8_BAR;
        PG8_WAIT_V(2); PG8_BAR;
        PG8_STB(PG8_SB(1, 0), cB + kstep, 0); PG8_STA(PG8_SA(1, 0), cA + kstep, 0, false); PG8_STB(PG8_SB(1, 1), cB + kstep, 1);
        PG8_WAIT_V(6); PG8_BAR;
    } else {
        PG8_STB(PG8_SB(0, 0), cB, 0); PG8_STA(PG8_SA(0, 0), cA, 0, false); PG8_STB(PG8_SB(0, 1), cB, 1); PG8_STA(PG8_SA(0, 1), cA, 1, false);
        if (wr == 1) PG8_BAR;
        PG8_WAIT_V(4); PG8_BAR;
        PG8_STB(PG8_SB(1, 0), cB + kstep, 0); PG8_STA(PG8_SA(1, 0), cA + kstep, 0, false); PG8_STB(PG8_SB(1, 1), cB + kstep, 1);
        PG8_WAIT_V(6); PG8_BAR;
    }
    for (;;) {
        const bool has_next = PG8_HAS(ui + 1);
        if (has_next) { PV.get(PG8_UNIT(ui + 1), nxt, ui + 1); if constexpr (Prov::GATHER) PG8_OFFS(nxt, nao); }
        else if constexpr (Prov::GATHER) {
#pragma unroll
            for (int h = 0; h < 2; ++h)
#pragma unroll
                for (int i = 0; i < 2; ++i) nao[h][i] = cao[h][i]; }
        const char* nA = has_next ? (const char*)nxt.A : cA; const char* nB = has_next ? (const char*)nxt.Bt : cB;
        const int nt = PV.kdim() >> 6;
#pragma unroll 1
        for (int t = 0; t < nt; t += 2) {
            const bool last = (t == nt - 2);
#define PG8_KOFF(t_) (Prov::ATILED ? ((size_t)((t_) >> 2) * 131072 + (size_t)((t_) & 3) * 128) : (size_t)(t_) * kstep)
            const char* a1 = cA + PG8_KOFF(t + 1);
            const char* a2 = last ? nA : cA + PG8_KOFF(t + 2); const char* b2 = last ? nB : cB + (size_t)(t + 2) * kstep;
            const char* a3 = a2 + kstep; const char* b3 = b2 + kstep;
            if constexpr (SP2) {
            PG8_LDB(B0, 0, 0); PG8_LDB(B1, 0, 1); PG8_SCHED; PG8_LDA(At, 0, 0); PG8_STA(PG8_SA(1, 1), a1, 1, false);
            PG8_WAIT_V(8); PG8_WAIT_L(0); PG8_BAR; PG8_MM(0, 0, At, B0); PG8_MM(0, 1, At, B1); PG8_BAR; PG8_SCHED;
            PG8_LDA(At, 0, 1); PG8_STB(PG8_SB(0, 0), b2, 0); PG8_STB(PG8_SB(0, 1), b2, 1); PG8_STA(PG8_SA(0, 0), a2, 0, last);
            PG8_WAIT_V(8); PG8_WAIT_L(0); PG8_BAR; PG8_MM(1, 0, At, B0); PG8_MM(1, 1, At, B1); PG8_BAR; PG8_SCHED;
            PG8_LDB(B0, 1, 0); PG8_LDB(B1, 1, 1); PG8_SCHED; PG8_LDA(At, 1, 0); PG8_STA(PG8_SA(0, 1), a2, 1, last);
            PG8_WAIT_V(8); PG8_WAIT_L(0); PG8_BAR; PG8_MM(0, 0, At, B0); PG8_MM(0, 1, At, B1); PG8_BAR; PG8_SCHED;
            PG8_LDA(At, 1, 1); PG8_STB(PG8_SB(1, 0), b3, 0); PG8_STB(PG8_SB(1, 1), b3, 1); PG8_STA(PG8_SA(1, 0), a3, 0, last);
            PG8_WAIT_V(8); PG8_WAIT_L(0); PG8_BAR; PG8_MM(1, 0, At, B0); PG8_MM(1, 1, At, B1); PG8_BAR; PG8_SCHED;
            } else {
            PG8_LDB(B0, 0, 0); PG8_SCHED; PG8_LDA(At, 0, 0); PG8_STA(PG8_SA(1, 1), a1, 1, false);
            PG8_WAIT_L(8); PG8_BAR; PG8_WAIT_L(0); PG8_MM(0, 0, At, B0); PG8_BAR; PG8_SCHED;
            PG8_LDB(B1, 0, 1); PG8_STB(PG8_SB(0, 0), b2, 0);
            PG8_BAR; PG8_WAIT_L(0); PG8_MM(0, 1, At, B1); PG8_BAR;
            PG8_LDA(At, 0, 1); PG8_STA(PG8_SA(0, 0), a2, 0, last);
            PG8_BAR; PG8_WAIT_L(0); PG8_MM(1, 0, At, B0); PG8_BAR; PG8_SCHED;
            PG8_STB(PG8_SB(0, 1), b2, 1);
            PG8_WAIT_V(6); PG8_BAR; PG8_MM(1, 1, At, B1); PG8_BAR;
            PG8_LDB(B0, 1, 0); PG8_SCHED; PG8_LDA(At, 1, 0); PG8_STA(PG8_SA(0, 1), a2, 1, last);
            PG8_WAIT_L(8); PG8_BAR; PG8_WAIT_L(0); PG8_MM(0, 0, At, B0); PG8_BAR; PG8_SCHED;
            PG8_LDB(B1, 1, 1); PG8_STB(PG8_SB(1, 0), b3, 0);
            PG8_BAR; PG8_WAIT_L(0); PG8_MM(0, 1, At, B1); PG8_BAR;
            PG8_LDA(At, 1, 1); PG8_STA(PG8_SA(1, 0), a3, 0, last);
            PG8_BAR; PG8_WAIT_L(0); PG8_MM(1, 0, At, B0); PG8_BAR; PG8_SCHED;
            PG8_STB(PG8_SB(1, 1), b3, 1);
            PG8_WAIT_V(6); PG8_BAR; PG8_MM(1, 1, At, B1); PG8_BAR;
            }
        }
        if constexpr (Prov::FP8) asm volatile("s_nop 15\n\ts_nop 15" ::: "memory");
        if constexpr (ALIGN_EPI) { if (wr == 0) PG8_BAR; }
        { asm volatile("" : "+v"(tid_m));
          E(acc, cur, wr, wc, tid_m & 15, (tid_m & 63) >> 4); }
        if (!has_next) break;
#pragma unroll
        for (int a = 0; a < 2; ++a)
#pragma unroll
            for (int b = 0; b < 2; ++b)
#pragma unroll
                for (int m = 0; m < 4; ++m)
#pragma unroll
                    for (int n = 0; n < 2; ++n) acc[a][b][m][n] = (f32x4){0.f, 0.f, 0.f, 0.f};
        cur = nxt; cA = nA; cB = nB; ++ui;
        if constexpr (Prov::GATHER) {
#pragma unroll
            for (int h = 0; h < 2; ++h)
#pragma unroll
                for (int i = 0; i < 2; ++i) cao[h][i] = nao[h][i]; }
        if constexpr (ALIGN_EPI) { if (wr == 1) PG8_BAR; }
    }
    PG8_WAIT_V(0);
    if constexpr (!ALIGN_EPI) { if (wr == 0) PG8_BAR; }
    PG8_BAR;
#undef PG8_SA
#undef PG8_SB
#undef PG8_STAGE
#undef PG8_STA
#undef PG8_STB
#undef PG8_LDA
#undef PG8_LDB
#undef PG8_MMA
#undef PG8_MMA8
#undef PG8_MM
#undef PG8_WAIT_V
#undef PG8_WAIT_L
#undef PG8_BAR
#undef PG8_SCHED
#undef PG8_OFFS
#undef PG8_KOFF
#undef PG8_HAS
#undef PG8_UNIT
}

#define EPI_FOR_ROWS for (int ai = 0; ai < 2; ++ai) for (int m = 0; m < 4; ++m)
#define EPI_ROW (ai * 128 + wr * 64 + m * 16 + fr)
#define EPI_COL8 (bj * 128 + wc * 32 + 8 * fq)
typedef f32x4 Acc[2][2][4][2];
__device__ __forceinline__ u32x4 pack8(const f32x4 a, const f32x4 b) { u32x4 w; w.x = cvt_pk_bf16(a[0], a[1]); w.y = cvt_pk_bf16(a[2], a[3]); w.z = cvt_pk_bf16(b[0], b[1]); w.w = cvt_pk_bf16(b[2], b[3]); return w; }
__device__ __forceinline__ void unpack8(const u32x4 w, f32x4& a, f32x4& b) { a[0] = lo16(w.x); a[1] = hi16(w.x); a[2] = lo16(w.y); a[3] = hi16(w.y); b[0] = lo16(w.z); b[1] = hi16(w.z); b[2] = lo16(w.w); b[3] = hi16(w.w); }
__device__ __forceinline__ f32x4 sig4(const f32x4 x) { f32x4 r; r[0] = sigmoidf_(x[0]); r[1] = sigmoidf_(x[1]); r[2] = sigmoidf_(x[2]); r[3] = sigmoidf_(x[3]); return r; }
__device__ __forceinline__ f32x4 silu4(const f32x4 x) { f32x4 r; r[0] = siluf_(x[0]); r[1] = siluf_(x[1]); r[2] = siluf_(x[2]); r[3] = siluf_(x[3]); return r; }

struct ProvDense {
    static constexpr bool GATHER = false, LOCAL = false, ATILED = false, TABLE = false, FP8 = false;
    const bf16* A; const bf16* Bt; int lda, K, nM, nN;
    __device__ __forceinline__ int count() const { return nM * nN; }
    __device__ __forceinline__ void get(int u, GUnit& g, int = 0) const { const int nig = 8 * nN, gid = u / nig, fm = gid * 8, gsz = (nM - fm) < 8 ? (nM - fm) : 8, loc = u % nig; g.pm = fm + loc % gsz; g.pn = loc / gsz; g.A = A + (size_t)g.pm * 256 * lda; g.Bt = Bt + (size_t)g.pn * 256 * K; g.gat = nullptr; }
    __device__ __forceinline__ int lda_() const { return lda; }
    __device__ __forceinline__ int ldb_() const { return K; }
    __device__ __forceinline__ int kdim() const { return K; }
};
template <bool PANEL>
struct ProvTiledA {
    static constexpr bool GATHER = false, LOCAL = PANEL, ATILED = true, TABLE = false, FP8 = false;
    const bf16* P; int pn0; const bf16* Bt; int nM, nN;
    __device__ __forceinline__ int count() const { if (PANEL) { const int np = (nM - (int)blockIdx.x + (int)gridDim.x - 1) / (int)gridDim.x; return np * nN; } return nM * nN; }
    __device__ __forceinline__ void get(int u, GUnit& g, int = 0) const {
        if (PANEL) { g.pm = (int)blockIdx.x + (u / nN) * (int)gridDim.x; g.pn = u % nN; }
        else { const int nig = 8 * nN, gid = u / nig, fm = gid * 8, gsz = (nM - fm) < 8 ? (nM - fm) : 8, loc = u % nig; g.pm = fm + loc % gsz; g.pn = loc / gsz; }
        g.A = P + (((size_t)g.pm * NPT + pn0) << 16); g.Bt = Bt + (size_t)g.pn * 256 * 1024; g.gat = nullptr; }
    __device__ __forceinline__ int lda_() const { return 256; }
    __device__ __forceinline__ int ldb_() const { return 1024; }
    __device__ __forceinline__ int kdim() const { return 1024; }
};
struct ProvDense8 {
    static constexpr bool GATHER = false, LOCAL = false, ATILED = false, TABLE = false, FP8 = true;
    const unsigned char* A; const unsigned char* Bt; int K, nM, nN;
    __device__ __forceinline__ int count() const { return nM * nN; }
    __device__ __forceinline__ void get(int u, GUnit& g, int = 0) const { const int nig = 8 * nN, gid = u / nig, fm = gid * 8, gsz = (nM - fm) < 8 ? (nM - fm) : 8, loc = u % nig; g.pm = fm + loc % gsz; g.pn = loc / gsz; g.A = (const bf16*)(A + (size_t)g.pm * 256 * K); g.Bt = (const bf16*)(Bt + (size_t)g.pn * 256 * K); g.gat = nullptr; }
    __device__ __forceinline__ int lda_() const { return K / 2; }
    __device__ __forceinline__ int ldb_() const { return K / 2; }
    __device__ __forceinline__ int kdim() const { return K / 2; }
};
struct ProvPanel {
    static constexpr bool GATHER = false, LOCAL = true, ATILED = false, TABLE = false, FP8 = false;
    const bf16* A; const bf16* Bt; int lda, K, nM, nN;
    __device__ __forceinline__ int count() const { const int np = (nM - (int)blockIdx.x + (int)gridDim.x - 1) / (int)gridDim.x; return np * nN; }
    __device__ __forceinline__ void get(int u, GUnit& g, int = 0) const { g.pm = (int)blockIdx.x + (u / nN) * (int)gridDim.x; g.pn = u % nN; g.A = A + (size_t)g.pm * 256 * lda; g.Bt = Bt + (size_t)g.pn * 256 * K; g.gat = nullptr; }
    __device__ __forceinline__ int lda_() const { return lda; }
    __device__ __forceinline__ int ldb_() const { return K; }
    __device__ __forceinline__ int kdim() const { return K; }
};
constexpr int PG_TAB_OFF = 131072 + 1024;
struct ProvPanel8 {
    static constexpr bool GATHER = false, LOCAL = true, ATILED = false, TABLE = false, FP8 = true;
    const unsigned char* A; const unsigned char* Bt; int K, nM, nN, pa;
    __device__ __forceinline__ int count() const { const int np = (nM - (int)blockIdx.x + (int)gridDim.x - 1) / (int)gridDim.x; return np * nN; }
    __device__ __forceinline__ void get(int u, GUnit& g, int = 0) const { g.pm = (int)blockIdx.x + (u / nN) * (int)gridDim.x; g.pn = u % nN; g.A = (const bf16*)(A + (size_t)g.pm * pa); g.Bt = (const bf16*)(Bt + (size_t)g.pn * 256 * K); g.gat = nullptr; }
    __device__ __forceinline__ int lda_() const { return K / 2; }
    __device__ __forceinline__ int ldb_() const { return K / 2; }
    __device__ __forceinline__ int kdim() const { return K / 2; }
};
struct ProvGateUp {
    static constexpr bool GATHER = true, LOCAL = false, ATILED = false, TABLE = true, FP8 = true;
    const unsigned char* H8; const unsigned char* Wgu; const int* stok; const int* tile_e; int ntiles; LAS int* tab;
    __device__ __forceinline__ int count() const { return ntiles * 2; }
    __device__ __forceinline__ int tab_val(int u) const { return tile_e[u >> 1]; }
    __device__ __forceinline__ void get(int u, GUnit& g, int li) const { g.pm = u >> 1; g.pn = u & 1; const int e = tab[li]; g.A = (const bf16*)H8; g.gat = stok + (size_t)g.pm * 256; g.Bt = (const bf16*)(Wgu + ((size_t)e * 2 + g.pn) * 256 * 1024); }
    __device__ __forceinline__ int lda_() const { return 512; }
    __device__ __forceinline__ int ldb_() const { return 512; }
    __device__ __forceinline__ int kdim() const { return 512; }
};
struct ProvDown {
    static constexpr bool GATHER = false, LOCAL = false, ATILED = false, TABLE = true, FP8 = true;
    const unsigned char* Act; const unsigned char* Wd; const int* tile_e; int ntiles, hf; LAS int* tab;
    __device__ __forceinline__ int count() const { return ntiles * 2; }
    __device__ __forceinline__ int tab_val(int u) const { return tile_e[u >> 1]; }
    __device__ __forceinline__ void get(int u, GUnit& g, int li) const { g.pm = u >> 1; g.pn = 2 * hf + (u & 1); const int e = tab[li]; g.A = (const bf16*)(Act + (size_t)g.pm * 256 * 256); g.gat = nullptr; g.Bt = (const bf16*)(Wd + ((size_t)e * 1024 + g.pn * 256) * 256); }
    __device__ __forceinline__ int lda_() const { return 128; }
    __device__ __forceinline__ int ldb_() const { return 128; }
    __device__ __forceinline__ int kdim() const { return 128; }
};

constexpr int EPI_BB_OFF = 131072 + 2048, EPI_BB_WAVE = 2048;
static_assert(EPI_BB_OFF + 8 * EPI_BB_WAVE <= MISC_OFF, "bounce buffers");
#define EPI_BB(lds_) ((lds_) + EPI_BB_OFF + (wr * 4 + wc) * EPI_BB_WAVE)
#define EPI_LANE (fq * 16 + fr)
__device__ __forceinline__ u32x4 bb_out64(LAS unsigned char* bb, int fr, int fq, u32x4 v) { *(LAS u32x4*)(bb + fr * 64 + fq * 16) = v; return *(const LAS u32x4*)(bb + (fq * 16 + fr) * 16); }
__device__ __forceinline__ u32x4 bb_in64(LAS unsigned char* bb, int fr, int fq, u32x4 v) { *(LAS u32x4*)(bb + (fq * 16 + fr) * 16) = v; return *(const LAS u32x4*)(bb + fr * 64 + fq * 16); }
__device__ __forceinline__ void bb_out128(LAS unsigned char* bb, int fr, int fq, f32x4 a, f32x4 b, f32x4& o0, f32x4& o1) {
    *(LAS f32x4*)(bb + fr * 128 + fq * 32) = a; *(LAS f32x4*)(bb + fr * 128 + fq * 32 + 16) = b; o0 = *(const LAS f32x4*)(bb + (fq * 16 + fr) * 16); o1 = *(const LAS f32x4*)(bb + 1024 + (fq * 16 + fr) * 16); }
__device__ __forceinline__ void bb_in128(LAS unsigned char* bb, int fr, int fq, f32x4 o0, f32x4 o1, f32x4& a, f32x4& b) {
    *(LAS f32x4*)(bb + (fq * 16 + fr) * 16) = o0; *(LAS f32x4*)(bb + 1024 + (fq * 16 + fr) * 16) = o1; a = *(const LAS f32x4*)(bb + fr * 128 + fq * 32); b = *(const LAS f32x4*)(bb + fr * 128 + fq * 32 + 16); }

constexpr float GATE8_SC = 256.0f;
struct EpiInProj { bf16* P; float* GL; LAS unsigned char* lds;
    __device__ __forceinline__ void operator()(const Acc& acc, const GUnit& g, int wr, int wc, int fr, int fq) const {
        LAS unsigned char* bb = EPI_BB(lds); const int l = EPI_LANE;
        if (g.pn >= C_GTA / 256 && g.pn < 28) {
            unsigned char* tile8 = (unsigned char*)P + (((size_t)g.pm * NPT + g.pn) << 17);
#pragma unroll
            EPI_FOR_ROWS { unsigned char* rowp = tile8 + (ai * 128 + wr * 64 + m * 16 + ((l & 31) >> 1)) * 256 + wc * 32 + (l & 1) * 16;
#pragma unroll
                for (int bj = 0; bj < 2; ++bj) { const f32x4 r0 = sig4(acc[ai][bj][m][0]) * GATE8_SC, r1 = sig4(acc[ai][bj][m][1]) * GATE8_SC;
                    u32x2 w; w.x = pk4_fp8(r0[0], r0[1], r0[2], r0[3]); w.y = pk4_fp8(r1[0], r1[1], r1[2], r1[3]);
                    *(LAS u32x2*)(bb + fr * 32 + fq * 8) = w;
                    const u32x4 o = *(const LAS u32x4*)(bb + (l & 31) * 16);
                    if (l < 32) *(u32x4*)(rowp + bj * 128) = o; } }
        } else if (g.pn < 28) {
            const bool ge = (g.pn >= C_GA / 256) && (g.pn < C_Q / 256), si = (g.pn >= C_R / 256) && (g.pn < C_GTA / 256);
#pragma unroll
            EPI_FOR_ROWS { bf16* rowp = P + (((size_t)g.pm * NPT + g.pn) << 16) + (ai * 128 + wr * 64 + m * 16 + (l >> 2)) * 256 + wc * 32 + 8 * (l & 3);
#pragma unroll
                for (int bj = 0; bj < 2; ++bj) { f32x4 v0 = acc[ai][bj][m][0], v1 = acc[ai][bj][m][1];
                    if (ge) { v0[0] = gelu_tanh(v0[0]); v0[1] = gelu_tanh(v0[1]); v0[2] = gelu_tanh(v0[2]); v0[3] = gelu_tanh(v0[3]); v1[0] = gelu_tanh(v1[0]); v1[1] = gelu_tanh(v1[1]); v1[2] = gelu_tanh(v1[2]); v1[3] = gelu_tanh(v1[3]); }
                    if (si) { v0 = silu4(v0); v1 = silu4(v1); }
                    *(u32x4*)(rowp + bj * 128) = bb_out64(bb, fr, fq, pack8(v0, v1)); } }
        } else if (wc == 0 && fq < 2) {
#pragma unroll
            EPI_FOR_ROWS { float* rowp = GL + ((size_t)g.pm * 256 + EPI_ROW) * 16 + 8 * fq; *(f32x4*)rowp = acc[ai][0][m][0]; *(f32x4*)(rowp + 4) = acc[ai][0][m][1]; }
        }
    } };
struct EpiGateMul {
    const bf16* P; int gcol; const unsigned char* base; bf16* out; unsigned char* out8; int opitch; LAS unsigned char* lds;
    __device__ __forceinline__ void operator()(const Acc& acc, const GUnit& g, int wr, int wc, int fr, int fq) const {
        LAS unsigned char* bb = EPI_BB(lds); const int l = EPI_LANE;
        const unsigned char* tile8 = (const unsigned char*)P + (((size_t)g.pm * NPT + (gcol >> 8) + g.pn) << 17);
#pragma unroll
        for (int ai = 0; ai < 2; ++ai)
#pragma unroll
          for (int mh = 0; mh < 2; ++mh) {
            u32x4 gt[2][2], bs[2][2];
#pragma unroll
            for (int m2 = 0; m2 < 2; ++m2)
#pragma unroll
                for (int bj = 0; bj < 2; ++bj) { const int m = 2 * mh + m2; const size_t row = (size_t)g.pm * 256 + ai * 128 + wr * 64 + m * 16 + (l >> 2); const int col = g.pn * 256 + bj * 128 + wc * 32 + 8 * (l & 3);
                    gt[m2][bj] = *(const u32x4*)(tile8 + (ai * 128 + wr * 64 + m * 16 + ((l & 31) >> 1)) * 256 + bj * 128 + wc * 32 + (l & 1) * 16);
                    if (base) bs[m2][bj] = *(const u32x4*)(base + (size_t)g.pm * H8_PANEL + (ai * 128 + wr * 64 + m * 16 + ((l & 31) >> 1)) * 1024 + g.pn * 256 + bj * 128 + wc * 32 + (l & 1) * 16); }
#pragma unroll
            for (int m2 = 0; m2 < 2; ++m2)
#pragma unroll
                for (int bj = 0; bj < 2; ++bj) { const int m = 2 * mh + m2; const size_t row = (size_t)g.pm * 256 + ai * 128 + wr * 64 + m * 16 + (l >> 2); const int col = g.pn * 256 + bj * 128 + wc * 32 + 8 * (l & 3);
                    *(LAS u32x4*)(bb + (l & 31) * 16) = gt[m2][bj]; const u32x2 gw = *(const LAS u32x2*)(bb + fr * 32 + fq * 8);
                    const f32x2_t a0 = __builtin_amdgcn_cvt_pk_f32_fp8((int)gw.x, false), a1 = __builtin_amdgcn_cvt_pk_f32_fp8((int)gw.x, true), a2 = __builtin_amdgcn_cvt_pk_f32_fp8((int)gw.y, false), a3 = __builtin_amdgcn_cvt_pk_f32_fp8((int)gw.y, true);
                    f32x4 r0 = (f32x4){a0.x, a0.y, a1.x, a1.y} * (1.0f / GATE8_SC) * acc[ai][bj][m][0], r1 = (f32x4){a2.x, a2.y, a3.x, a3.y} * (1.0f / GATE8_SC) * acc[ai][bj][m][1];
                    if (base) { *(LAS u32x4*)(bb + (l & 31) * 16) = bs[m2][bj]; const u32x2 bw = *(const LAS u32x2*)(bb + fr * 32 + fq * 8);
                        const f32x2_t c0 = __builtin_amdgcn_cvt_pk_f32_fp8((int)bw.x, false), c1 = __builtin_amdgcn_cvt_pk_f32_fp8((int)bw.x, true), c2 = __builtin_amdgcn_cvt_pk_f32_fp8((int)bw.y, false), c3 = __builtin_amdgcn_cvt_pk_f32_fp8((int)bw.y, true);
                        r0 += (f32x4){c0.x, c0.y, c1.x, c1.y} * (1.0f / (float)(1 << FP8_A_SHIFT)); r1 += (f32x4){c2.x, c2.y, c3.x, c3.y} * (1.0f / (float)(1 << FP8_A_SHIFT)); }
                    if (out8) { constexpr float SC = (float)(1 << FP8_A_SHIFT); u32x2 w8; w8.x = pk4_fp8(r0[0] * SC, r0[1] * SC, r0[2] * SC, r0[3] * SC); w8.y = pk4_fp8(r1[0] * SC, r1[1] * SC, r1[2] * SC, r1[3] * SC);
                        *(LAS u32x2*)(bb + fr * 32 + fq * 8) = w8; const u32x4 o = *(const LAS u32x4*)(bb + (l & 31) * 16);
                        if (l < 32) *(u32x4*)(out8 + (size_t)g.pm * opitch + (ai * 128 + wr * 64 + m * 16 + ((l & 31) >> 1)) * 1024 + g.pn * 256 + bj * 128 + wc * 32 + (l & 1) * 16) = o; }
                    else *(u32x4*)(out + row * 1024 + col) = bb_out64(bb, fr, fq, pack8(r0, r1)); }
          }
    } };
struct EpiHpre { const float* x; bf16* hp; LAS unsigned char* lds;
    __device__ __forceinline__ void operator()(const Acc& acc, const GUnit& g, int wr, int wc, int fr, int fq) const {
        LAS unsigned char* bb = EPI_BB(lds); const int l = EPI_LANE;
#pragma unroll
        for (int ai = 0; ai < 2; ++ai)
#pragma unroll
            for (int mh = 0; mh < 2; ++mh) {
                f32x4 xv[2][2][2];
#pragma unroll
                for (int m2 = 0; m2 < 2; ++m2)
#pragma unroll
                    for (int bj = 0; bj < 2; ++bj) { const float* xp = x + ((size_t)g.pm * 256 + ai * 128 + wr * 64 + (2 * mh + m2) * 16) * 1024 + g.pn * 256 + bj * 128 + wc * 32;
                        xv[m2][bj][0] = *(const f32x4*)(xp + (size_t)(l >> 3) * 1024 + 4 * (l & 7)); xv[m2][bj][1] = *(const f32x4*)(xp + (size_t)(8 + (l >> 3)) * 1024 + 4 * (l & 7)); }
#pragma unroll
                for (int m2 = 0; m2 < 2; ++m2)
#pragma unroll
                    for (int bj = 0; bj < 2; ++bj) { const int m = 2 * mh + m2; f32x4 x0, x1; bb_in128(bb, fr, fq, xv[m2][bj][0], xv[m2][bj][1], x0, x1);
                        *(u32x4*)(hp + ((size_t)g.pm * 256 + ai * 128 + wr * 64 + m * 16 + (l >> 2)) * 1024 + g.pn * 256 + bj * 128 + wc * 32 + 8 * (l & 3)) = bb_out64(bb, fr, fq, pack8(x0 * DN_ALPHA + acc[ai][bj][m][0], x1 * DN_ALPHA + acc[ai][bj][m][1])); }
            }
    } };
struct EpiF32 { float* C; int ldc; LAS unsigned char* lds;
    __device__ __forceinline__ void operator()(const Acc& acc, const GUnit& g, int wr, int wc, int fr, int fq) const {
        LAS unsigned char* bb = EPI_BB(lds); const int l = EPI_LANE;
#pragma unroll
        EPI_FOR_ROWS {
#pragma unroll
            for (int bj = 0; bj < 2; ++bj) { f32x4 o0, o1; bb_out128(bb, fr, fq, acc[ai][bj][m][0], acc[ai][bj][m][1], o0, o1);
                float* cp = C + ((size_t)g.pm * 256 + ai * 128 + wr * 64 + m * 16) * ldc + g.pn * 256 + bj * 128 + wc * 32;
                *(f32x4*)(cp + (size_t)(l >> 3) * ldc + 4 * (l & 7)) = o0; *(f32x4*)(cp + (size_t)(8 + (l >> 3)) * ldc + 4 * (l & 7)) = o1; } }
    } };
struct EpiSwiglu { bf16* out; LAS unsigned char* lds;
    __device__ __forceinline__ void operator()(const Acc& acc, const GUnit& g, int wr, int wc, int fr, int fq) const {
        LAS unsigned char* bb = EPI_BB(lds); const int l = EPI_LANE;
#pragma unroll
        EPI_FOR_ROWS {
            const f32x4 r0 = silu4(acc[ai][0][m][0]) * acc[ai][1][m][0], r1 = silu4(acc[ai][0][m][1]) * acc[ai][1][m][1];
            *(u32x4*)(out + ((size_t)g.pm * 256 + ai * 128 + wr * 64 + m * 16 + (l >> 2)) * 256 + g.pn * 128 + wc * 32 + 8 * (l & 3)) = bb_out64(bb, fr, fq, pack8(r0, r1)); }
    } };
struct EpiShDown { bf16* H; LAS unsigned char* lds;
    __device__ __forceinline__ void operator()(const Acc& acc, const GUnit& g, int wr, int wc, int fr, int fq) const {
        LAS unsigned char* bb = EPI_BB(lds); const int l = EPI_LANE;
#pragma unroll
        for (int ai = 0; ai < 2; ++ai) {
            u32x4 hv[4][2];
#pragma unroll
            for (int m = 0; m < 4; ++m)
#pragma unroll
                for (int bj = 0; bj < 2; ++bj) hv[m][bj] = *(const u32x4*)(H + ((size_t)g.pm * 256 + ai * 128 + wr * 64 + m * 16 + (l >> 2)) * 1024 + g.pn * 256 + bj * 128 + wc * 32 + 8 * (l & 3));
#pragma unroll
            for (int m = 0; m < 4; ++m)
#pragma unroll
                for (int bj = 0; bj < 2; ++bj) { f32x4 h0, h1; unpack8(bb_in64(bb, fr, fq, hv[m][bj]), h0, h1);
                    *(u32x4*)(H + ((size_t)g.pm * 256 + ai * 128 + wr * 64 + m * 16 + (l >> 2)) * 1024 + g.pn * 256 + bj * 128 + wc * 32 + 8 * (l & 3)) = bb_out64(bb, fr, fq, pack8(h0 * DN_ALPHA + acc[ai][bj][m][0], h1 * DN_ALPHA + acc[ai][bj][m][1])); }
        }
    } };
struct EpiSwiglu8 { unsigned char* out; LAS unsigned char* lds;
    __device__ __forceinline__ void operator()(const Acc& acc, const GUnit& g, int wr, int wc, int fr, int fq) const {
        LAS unsigned char* bb = EPI_BB(lds); const int l = EPI_LANE; constexpr float SC = (float)(1 << FP8_A_SHIFT);
#pragma unroll
        EPI_FOR_ROWS { const f32x4 r0 = silu4(acc[ai][0][m][0]) * acc[ai][1][m][0] * SC, r1 = silu4(acc[ai][0][m][1]) * acc[ai][1][m][1] * SC;
            u32x2 w; w.x = pk4_fp8(r0[0], r0[1], r0[2], r0[3]); w.y = pk4_fp8(r1[0], r1[1], r1[2], r1[3]);
            *(LAS u32x2*)(bb + fr * 32 + fq * 8) = w;
            const u32x4 o = *(const LAS u32x4*)(bb + (l & 31) * 16);
            if (l < 32) *(u32x4*)(out + ((size_t)g.pm * 256 + ai * 128 + wr * 64 + m * 16 + (l >> 1)) * 256 + g.pn * 128 + wc * 32 + (l & 1) * 16) = o; }
    } };
struct EpiFp8Tile { unsigned char* out; LAS unsigned char* lds;
    __device__ __forceinline__ void operator()(const Acc& acc, const GUnit& g, int wr, int wc, int fr, int fq) const {
        LAS unsigned char* bb = EPI_BB(lds); const int l = EPI_LANE; constexpr float SC = (float)(1 << FP8_Y_SHIFT);
#pragma unroll
        EPI_FOR_ROWS { unsigned char* rowp = out + ((size_t)g.pm * 256 + ai * 128 + wr * 64 + m * 16 + ((l & 31) >> 1)) * 1024 + g.pn * 256 + wc * 32 + (l & 1) * 16;
#pragma unroll
            for (int bj = 0; bj < 2; ++bj) { const f32x4 r0 = acc[ai][bj][m][0] * SC, r1 = acc[ai][bj][m][1] * SC;
                u32x2 w; w.x = pk4_fp8(r0[0], r0[1], r0[2], r0[3]); w.y = pk4_fp8(r1[0], r1[1], r1[2], r1[3]);
                *(LAS u32x2*)(bb + fr * 32 + fq * 8) = w;
                const u32x4 o = *(const LAS u32x4*)(bb + (l & 31) * 16);
                if (l < 32) *(u32x4*)(rowp + bj * 128) = o; } }
    } };

constexpr int GL_WUP = 0, GL_BG = 8192, GL_NG = 8704, GL_GD = 9728, GL_SS = 10240, GL_RS = 12288, GL_QD = 12800, GL_KI = GL_QD + 17408, GL_KET = GL_KI + 17408, GL_VT = GL_KET + 18432, GL_PM = GL_VT + 36864, GL_BT = GL_PM + 9216;
static_assert(GL_PM + 9216 <= 131072 && 64 * 264 * 2 <= 2 * 17408 && GL_BT + 8 * 64 * 20 * 4 <= MISC_OFF, "GLA LDS");
constexpr int QS = 136, TS = 72, VRS = 264;
typedef short v4i16_t __attribute__((ext_vector_type(4)));
static_assert(64 * VRS * 2 <= 36864, "GLA V image");

__device__ __forceinline__ void gla_unit(Frame& F, int b, int h) {
    PHASE_IDS(F);
    LAS unsigned char* L = F.lds;
    LAS float* WUP = (LAS float*)(L + GL_WUP); LAS float* BG = (LAS float*)(L + GL_BG); LAS float* NG = (LAS float*)(L + GL_NG);
    LAS float* GD = (LAS float*)(L + GL_GD); LAS float* SS = (LAS float*)(L + GL_SS); LAS float* RS = (LAS float*)(L + GL_RS);
    LAS bf16* QD = (LAS bf16*)(L + GL_QD); LAS bf16* KI = (LAS bf16*)(L + GL_KI); LAS bf16* KET = (LAS bf16*)(L + GL_KET); LAS bf16* VT = (LAS bf16*)(L + GL_VT); LAS bf16* PM = (LAS bf16*)(L + GL_PM);
    const int tid = F.tid, lane = F.lane, w = F.wave, fr = lane & 15, fq = lane >> 4;
    bf16* P = WSP(bf16, WS_P); const float* GLW = WSP(float, WS_GL);
    __syncthreads();
    float wB[4], LA[4];
#pragma unroll
    for (int s4 = 0; s4 < 4; ++s4) { wB[s4] = F.in[10][(4 * fq + s4) * 512 + h * 128 + 16 * w + fr]; LA[s4] = (s4 < (fr & 3) || (s4 == (fr & 3) && fq < (fr >> 2))) ? 1.0f : 0.0f; }
    const float biasv = F.in[11][h * 128 + 16 * w + fr];
    if (tid < 256) NG[tid] = F.in[12][h * 256 + tid];
    f32x4 S[8][2];
#pragma unroll
    for (int kt = 0; kt < 8; ++kt) { S[kt][0] = (f32x4){0.f, 0.f, 0.f, 0.f}; S[kt][1] = (f32x4){0.f, 0.f, 0.f, 0.f}; }
    __syncthreads();
    const int dv0 = 32 * w;
    f32x4 gvn[4];
#pragma unroll
    for (int mt = 0; mt < 4; ++mt) gvn[mt] = *(const f32x4*)(GLW + ((size_t)b * SEQ + 16 * mt + fr) * 16 + 4 * fq);
    for (int ch = 0; ch < 32; ++ch) {
        const size_t row0 = (size_t)b * SEQ + 64 * ch;
        const size_t pan = row0 >> 8; const int r0l = (int)(row0 & 255);
        const bf16* tq = P + ((pan * NPT + (C_Q >> 8) + (h >> 1)) << 16) + (h & 1) * 128; const bf16* tk = P + ((pan * NPT + (C_K >> 8) + (h >> 1)) << 16) + (h & 1) * 128;
        const bf16* tv = P + ((pan * NPT + (C_V >> 8) + h) << 16); bf16* tr = P + ((pan * NPT + (C_R >> 8) + h) << 16);
        { float la[16], blv[16];
          u32x4 qv[2], kv[2], vvv[4];
          { const bf16* qp = tq + (r0l + lane) * 256 + 16 * w; qv[0] = *(const u32x4*)qp; qv[1] = *(const u32x4*)(qp + 8); }
          { const bf16* kp = tk + (r0l + lane) * 256 + 16 * w; kv[0] = *(const u32x4*)kp; kv[1] = *(const u32x4*)(kp + 8); }
#pragma unroll
          for (int i = 0; i < 4; ++i) vvv[i] = *(const u32x4*)(tv + (r0l + lane) * 256 + dv0 + 8 * i);
          { f32x4 lg[4], gv[4];
#define MFMA_F32X4(acc_, a_, b_) asm volatile("s_nop 1\n\tv_mfma_f32_16x16x4_f32 %0, %1, %2, %0" : "+v"(acc_) : "v"(a_), "v"(b_))
#define MFMA_F32X4_LAST(acc_, a_, b_) asm volatile("s_nop 1\n\tv_mfma_f32_16x16x4_f32 %0, %1, %2, %0\n\ts_nop 15" : "+v"(acc_) : "v"(a_), "v"(b_))
#define MFMA_F32X4_DEP_LAST(acc_, a_, b_) asm volatile("s_nop 9\n\tv_mfma_f32_16x16x4_f32 %0, %1, %2, %0\n\ts_nop 15" : "+v"(acc_) : "v"(a_), "v"(b_))
#define MFMA_F32X4_DEP(acc_, a_, b_) asm volatile("s_nop 9\n\tv_mfma_f32_16x16x4_f32 %0, %1, %2, %0" : "+v"(acc_) : "v"(a_), "v"(b_))
#pragma unroll
            for (int mt = 0; mt < 4; ++mt) { gv[mt] = gvn[mt]; lg[mt] = (f32x4){biasv, biasv, biasv, biasv}; }
#pragma unroll
            for (int s4 = 0; s4 < 4; ++s4)
#pragma unroll
                for (int mt = 0; mt < 4; ++mt) if (s4 < 3) MFMA_F32X4(lg[mt], gv[mt][s4], wB[s4]);
            asm volatile("s_nop 1\n\tv_mfma_f32_16x16x4_f32 %0, %4, %8, %0\n\tv_mfma_f32_16x16x4_f32 %1, %5, %8, %1\n\tv_mfma_f32_16x16x4_f32 %2, %6, %8, %2\n\tv_mfma_f32_16x16x4_f32 %3, %7, %8, %3\n\ts_nop 15"
                         : "+v"(lg[0]), "+v"(lg[1]), "+v"(lg[2]), "+v"(lg[3]) : "v"(gv[0][3]), "v"(gv[1][3]), "v"(gv[2][3]), "v"(gv[3][3]), "v"(wB[3]));
            if (ch + 1 < 32) {
#pragma unroll
                for (int mt = 0; mt < 4; ++mt) gvn[mt] = *(const f32x4*)(GLW + (row0 + 64 + 16 * mt + fr) * 16 + 4 * fq); }
#pragma unroll
            for (int mt = 0; mt < 4; ++mt) {
#pragma unroll
                for (int r = 0; r < 4; ++r) { const float x = lg[mt][r]; lg[mt][r] = (fminf(x, 0.f) - __builtin_amdgcn_logf(1.0f + __expf(-fabsf(x))) * 0.6931471805599453f) * (1.0f / 16.0f); }
                lg[mt][1] += lg[mt][0]; lg[mt][2] += lg[mt][1]; lg[mt][3] += lg[mt][2]; }
            f32x4 ex = (f32x4){0.f, 0.f, 0.f, 0.f};
#pragma unroll
            for (int kt = 0; kt < 4; ++kt) { if (kt < 3) MFMA_F32X4_DEP(ex, LA[kt], lg[kt][3]); else MFMA_F32X4_DEP_LAST(ex, LA[kt], lg[kt][3]); }
#undef MFMA_F32X4
#undef MFMA_F32X4_DEP
#undef MFMA_F32X4_LAST
#undef MFMA_F32X4_DEP_LAST
            LAS float* BT = (LAS float*)(L + GL_BT) + w * (64 * 20);
#pragma unroll
            for (int mt = 0; mt < 4; ++mt)
#pragma unroll
                for (int r = 0; r < 4; ++r) BT[(16 * mt + 4 * fq + r) * 20 + fr] = lg[mt][r] + ex[mt];
            if (fq == 3) GD[16 * w + fr] = __expf(lg[3][3] + ex[3]);
#pragma unroll
            for (int i = 0; i < 4; ++i) { const f32x4 t = *(const LAS f32x4*)(BT + lane * 20 + 4 * i), u = *(const LAS f32x4*)(GD + 16 * w + 4 * i);
                la[4 * i] = t[0]; la[4 * i + 1] = t[1]; la[4 * i + 2] = t[2]; la[4 * i + 3] = t[3]; blv[4 * i] = u[0]; blv[4 * i + 1] = u[1]; blv[4 * i + 2] = u[2]; blv[4 * i + 3] = u[3]; } }
          unsigned qo[8], ko[8];
#pragma unroll
          for (int j2 = 0; j2 < 8; ++j2) {
              const unsigned qw = qv[j2 >> 2][j2 & 3], kw = kv[j2 >> 2][j2 & 3];
              const float b0 = la[2 * j2], b1 = la[2 * j2 + 1];
              const float bl0 = blv[2 * j2], bl1 = blv[2 * j2 + 1];
              const float e0 = __builtin_amdgcn_exp2f(fmaf(b0, 1.4426950408889634f, -3.5f)), e1 = __builtin_amdgcn_exp2f(fmaf(b1, 1.4426950408889634f, -3.5f)), i0 = __builtin_amdgcn_exp2f(b0 * -1.4426950408889634f), i1 = __builtin_amdgcn_exp2f(b1 * -1.4426950408889634f);
              qo[j2] = pk2(lo16(qw) * e0, hi16(qw) * e1);
              const float ki0 = lo16(kw) * i0, ki1 = hi16(kw) * i1;
              ko[j2] = pk2(ki0, ki1);
              const float g0 = bl0, g1 = bl1; const float ke0 = ki0 * g0, ke1 = ki1 * g1;
              KET[(16 * w + 2 * j2) * TS + lane] = (bf16)f2bf(ke0); KET[(16 * w + 2 * j2 + 1) * TS + lane] = (bf16)f2bf(ke1);
          }
          *(LAS u32x4*)(QD + lane * QS + 16 * w) = (u32x4){qo[0], qo[1], qo[2], qo[3]}; *(LAS u32x4*)(QD + lane * QS + 16 * w + 8) = (u32x4){qo[4], qo[5], qo[6], qo[7]};
          *(LAS u32x4*)(KI + lane * QS + 16 * w) = (u32x4){ko[0], ko[1], ko[2], ko[3]}; *(LAS u32x4*)(KI + lane * QS + 16 * w + 8) = (u32x4){ko[4], ko[5], ko[6], ko[7]};
#pragma unroll
          for (int i = 0; i < 4; ++i) *(LAS u32x4*)(VT + lane * VRS + dv0 + 8 * i) = vvv[i];
        }
        __syncthreads();
#pragma unroll
        for (int tt = 0; tt < 2; ++tt) { const int tl = 2 * w + tt, it = tl >> 2, jt = tl & 3;
            f32x4 acc = (f32x4){0.f, 0.f, 0.f, 0.f};
            if (jt <= it) {
#pragma unroll
                for (int ks = 0; ks < 4; ++ks) { const bf16x8 a = *(const LAS bf16x8*)(QD + (16 * it + fr) * QS + 32 * ks + 8 * fq); const bf16x8 bb = *(const LAS bf16x8*)(KI + (16 * jt + fr) * QS + 32 * ks + 8 * fq);
                    acc = __builtin_amdgcn_mfma_f32_16x16x32_bf16(a, bb, acc, 0, 0, 0); } }
#pragma unroll
            for (int r = 0; r < 4; ++r) { const int i = 16 * it + 4 * fq + r, j = 16 * jt + fr; PM[i * TS + j] = (j <= i) ? (bf16)f2bf(acc[r]) : (bf16)0; } }
        __syncthreads();
        u32x4 rpre[4];
#pragma unroll
        for (int i = 0; i < 4; ++i) { const int idx = tid + 512 * i, tok = idx >> 5, c = (idx & 31) * 8; rpre[i] = *(const u32x4*)(tr + (r0l + tok) * 256 + c); }
        bf16x8 vb[2][2];
#pragma unroll
        for (int ks = 0; ks < 2; ++ks)
#pragma unroll
            for (int nt = 0; nt < 2; ++nt) {
                const LAS bf16* vp = VT + (32 * ks + 8 * fq + (fr >> 2)) * VRS + dv0 + 16 * nt + 4 * (fr & 3);
                const v4i16_t lo = __builtin_amdgcn_ds_read_tr16_b64_v4i16((LAS v4i16_t*)vp), hi = __builtin_amdgcn_ds_read_tr16_b64_v4i16((LAS v4i16_t*)(vp + 4 * VRS));
                vb[ks][nt] = __builtin_shufflevector(lo, hi, 0, 1, 2, 3, 4, 5, 6, 7); }
        f32x4 o[4][2];
#pragma unroll
        for (int mt = 0; mt < 4; ++mt) { o[mt][0] = (f32x4){0.f, 0.f, 0.f, 0.f}; o[mt][1] = (f32x4){0.f, 0.f, 0.f, 0.f}; }
#pragma unroll
        for (int k4 = 0; k4 < 4; ++k4) {
            bf16x8 sb[2];
#pragma unroll
            for (int nt = 0; nt < 2; ++nt) { const f32x4 s0 = S[2 * k4][nt], s1 = S[2 * k4 + 1][nt]; u32x4 pw; pw.x = pk2(s0[0], s0[1]); pw.y = pk2(s0[2], s0[3]); pw.z = pk2(s1[0], s1[1]); pw.w = pk2(s1[2], s1[3]); sb[nt] = __builtin_bit_cast(bf16x8, pw); }
#pragma unroll
            for (int mt = 0; mt < 4; ++mt) { const u32x2 q0 = *(const LAS u32x2*)(QD + (16 * mt + fr) * QS + 32 * k4 + 4 * fq); const u32x2 q1 = *(const LAS u32x2*)(QD + (16 * mt + fr) * QS + 32 * k4 + 16 + 4 * fq);
                const bf16x8 aq = __builtin_bit_cast(bf16x8, (u32x4){q0.x, q0.y, q1.x, q1.y});
                o[mt][0] = __builtin_amdgcn_mfma_f32_16x16x32_bf16(aq, sb[0], o[mt][0], 0, 0, 0); o[mt][1] = __builtin_amdgcn_mfma_f32_16x16x32_bf16(aq, sb[1], o[mt][1], 0, 0, 0); } }
#pragma unroll
        for (int mt = 0; mt < 4; ++mt)
#pragma unroll
            for (int ks = 0; ks < 2; ++ks) if (ks <= (mt >> 1)) { const bf16x8 ap = *(const LAS bf16x8*)(PM + (16 * mt + fr) * TS + 32 * ks + 8 * fq);
                o[mt][0] = __builtin_amdgcn_mfma_f32_16x16x32_bf16(ap, vb[ks][0], o[mt][0], 0, 0, 0); o[mt][1] = __builtin_amdgcn_mfma_f32_16x16x32_bf16(ap, vb[ks][1], o[mt][1], 0, 0, 0); }
#pragma unroll
        for (int kt = 0; kt < 8; ++kt) { const f32x4 gd = *(const LAS f32x4*)(GD + 16 * kt + 4 * fq);
            S[kt][0] = S[kt][0] * gd; S[kt][1] = S[kt][1] * gd;
#pragma unroll
            for (int ks = 0; ks < 2; ++ks) { const bf16x8 ak = *(const LAS bf16x8*)(KET + (16 * kt + fr) * TS + 32 * ks + 8 * fq);
                S[kt][0] = __builtin_amdgcn_mfma_f32_16x16x32_bf16(ak, vb[ks][0], S[kt][0], 0, 0, 0); S[kt][1] = __builtin_amdgcn_mfma_f32_16x16x32_bf16(ak, vb[ks][1], S[kt][1], 0, 0, 0); } }
        { float ss[16];
#pragma unroll
          for (int mt = 0; mt < 4; ++mt)
#pragma unroll
              for (int r = 0; r < 4; ++r) ss[4 * mt + r] = o[mt][0][r] * o[mt][0][r] + o[mt][1][r] * o[mt][1][r];
#define GLA_RED8(D, o_) asm volatile("s_nop 1\n\tv_add_f32_dpp %0, %0, %0 row_shr:" #D " row_mask:0xf bank_mask:0xf\n\tv_add_f32_dpp %1, %1, %1 row_shr:" #D " row_mask:0xf bank_mask:0xf\n\tv_add_f32_dpp %2, %2, %2 row_shr:" #D " row_mask:0xf bank_mask:0xf\n\tv_add_f32_dpp %3, %3, %3 row_shr:" #D " row_mask:0xf bank_mask:0xf\n\t" \
              "v_add_f32_dpp %4, %4, %4 row_shr:" #D " row_mask:0xf bank_mask:0xf\n\tv_add_f32_dpp %5, %5, %5 row_shr:" #D " row_mask:0xf bank_mask:0xf\n\tv_add_f32_dpp %6, %6, %6 row_shr:" #D " row_mask:0xf bank_mask:0xf\n\tv_add_f32_dpp %7, %7, %7 row_shr:" #D " row_mask:0xf bank_mask:0xf" \
              : "+v"(ss[o_]), "+v"(ss[o_ + 1]), "+v"(ss[o_ + 2]), "+v"(ss[o_ + 3]), "+v"(ss[o_ + 4]), "+v"(ss[o_ + 5]), "+v"(ss[o_ + 6]), "+v"(ss[o_ + 7]))
          GLA_RED8(1, 0); GLA_RED8(1, 8); GLA_RED8(2, 0); GLA_RED8(2, 8); GLA_RED8(4, 0); GLA_RED8(4, 8); GLA_RED8(8, 0); GLA_RED8(8, 8);
#undef GLA_RED8
          if (fr == 15) {
#pragma unroll
              for (int mt = 0; mt < 4; ++mt) *(LAS f32x4*)(SS + w * 64 + 16 * mt + 4 * fq) = (f32x4){ss[4 * mt], ss[4 * mt + 1], ss[4 * mt + 2], ss[4 * mt + 3]}; } }
        __syncthreads();
        { LAS bf16* OT = (LAS bf16*)(L + GL_QD);
#pragma unroll
          for (int mt = 0; mt < 4; ++mt)
#pragma unroll
              for (int r = 0; r < 4; ++r) { const int tok = 16 * mt + 4 * fq + r;
#pragma unroll
                  for (int nt = 0; nt < 2; ++nt) { const int dv = dv0 + 16 * nt + fr; OT[tok * 264 + dv] = (bf16)f2bf(o[mt][nt][r] * NG[dv]); } }
          __syncthreads();
#pragma unroll
          for (int i = 0; i < 4; ++i) { const int idx = tid + 512 * i, tok = idx >> 5, c = (idx & 31) * 8;
              const u32x4 ov = *(const LAS u32x4*)(OT + tok * 264 + c); const int po = (r0l + tok) * 256 + c; const u32x4 rv = rpre[i]; u32x4 w;
              float t = 0.f;
#pragma unroll
              for (int ww = 0; ww < 8; ++ww) t += SS[ww * 64 + tok];
              const float rs = __builtin_amdgcn_rsqf(t * (1.0f / 256.0f) + RMS_EPS);
              constexpr float SC = (float)(1 << FP8_A_SHIFT); float f[8];
              const float rsc = rs * SC;
#pragma unroll
              for (int j = 0; j < 4; ++j) { f[2 * j] = (lo16(ov[j]) * lo16(rv[j])) * rsc; f[2 * j + 1] = (hi16(ov[j]) * hi16(rv[j])) * rsc; }
              u32x2 o8; o8.x = pk4_fp8(f[0], f[1], f[2], f[3]); o8.y = pk4_fp8(f[4], f[5], f[6], f[7]); (void)w; (void)po;
              *(u32x2*)((unsigned char*)F.out + pan * H8_PANEL + 262144 + (size_t)(r0l + tok) * 1024 + h * 256 + c) = o8; }
          __syncthreads(); }
    }
}

constexpr int LR_CW = 0, LR_CB = 1024, LR_BA = 1280, LR_BX = 1536, LR_SP = 1792, LR_HC = 2048, LR_AGG = 2304, LR_HIN = 6400, LR_W = 8448, LR_XA = 24832, LR_GA = LR_XA + 259 * 144 + 16  , LR_RS = 144;
static_assert(LR_XA % 16 == 0 && LR_GA % 16 == 0 && LR_GA + 256 * 144 <= 131072, "LRU LDS");

__device__ __forceinline__ void lru_unit(Frame& F, int b, int g) {
    F.lane = F.tid & 63; F.wave = __builtin_amdgcn_readfirstlane(F.tid >> 6);
    LAS unsigned char* L = F.lds;
    LAS float* CW = (LAS float*)(L + LR_CW); LAS float* CB = (LAS float*)(L + LR_CB); LAS float* BA = (LAS float*)(L + LR_BA); LAS float* BX = (LAS float*)(L + LR_BX);
    LAS float* SP = (LAS float*)(L + LR_SP); LAS float* HC = (LAS float*)(L + LR_HC); LAS float* AGG = (LAS float*)(L + LR_AGG); LAS float* HIN = (LAS float*)(L + LR_HIN); LAS bf16* WL = (LAS bf16*)(L + LR_W);
    const int tid = F.tid, lane = F.lane, w = F.wave, fr = lane & 15, fq = lane >> 4;
    bf16* P = WSP(bf16, WS_P);
    __syncthreads();
    if (tid < 256) CW[tid] = F.in[2][(tid >> 6) * 1024 + 64 * g + (tid & 63)];
    if (tid < 64) { const int c = 64 * g + tid; CB[tid] = F.in[3][c]; BA[tid] = F.in[5][c]; BX[tid] = F.in[7][c]; const float lam = F.in[8][c];
        SP[tid] = -1.4426950408889634f * 8.0f * (fmaxf(-lam, 0.f) + log1pf(__expf(-fabsf(lam)))); HC[tid] = 0.f; }
    { const u32x4* src = (const u32x4*)(WSP(bf16, WS_LRUW) + (size_t)g * 2 * 4096); LAS u32x4* dst = (LAS u32x4*)WL; dst[tid] = src[tid]; dst[tid + 512] = src[tid + 512]; }
    __syncthreads();
    LAS unsigned char* XA = L + LR_XA; LAS unsigned char* GA = L + LR_GA;
    u32x4 pfx[5], pfg[4];
#define LRU_PREFETCH(stn) do { int tz_ = tid; asm volatile("" : "+v"(tz_)); const int t0_ = (stn) * 256; const size_t pn_ = ((size_t)b * SEQ + t0_) >> 8; \
        const bf16* txa_ = P + ((pn_ * NPT + (C_XA >> 8) + (g >> 2)) << 16) + (g & 3) * 64; const bf16* tga_ = P + ((pn_ * NPT + (C_GA >> 8) + (g >> 2)) << 16) + (g & 3) * 64; \
        _Pragma("unroll") for (int i = 0; i < 5; ++i) { const int p = tz_ + 512 * i; pfx[i] = (u32x4){0u, 0u, 0u, 0u}; if (p < 259 * 8) { const int r = p >> 3, c16 = p & 7, t = t0_ - 3 + r; \
            if (t >= 0) pfx[i] = *(const u32x4*)(txa_ + (r >= 3 ? (r - 3) * 256 : (r - 3 + 256) * 256 - (NPT << 16)) + 8 * c16); } } \
        _Pragma("unroll") for (int i = 0; i < 4; ++i) { const int p = tz_ + 512 * i, r = p >> 3, c16 = p & 7; pfg[i] = *(const u32x4*)(tga_ + r * 256 + 8 * c16); } } while (0)
    LRU_PREFETCH(0);
    for (int st = 0; st < 8; ++st) {
        const int tb = st * 256 + w * 32, t0 = st * 256;
        __syncthreads();
        int tz = tid; asm volatile("" : "+v"(tz));
        const size_t panl = ((size_t)b * SEQ + t0) >> 8;
        bf16* tga = P + ((panl * NPT + (C_GA >> 8) + (g >> 2)) << 16) + (g & 3) * 64;
#pragma unroll
        for (int i = 0; i < 5; ++i) { const int p = tz + 512 * i; if (p < 259 * 8) { const int r = p >> 3, c16 = p & 7; *(LAS u32x4*)(XA + r * LR_RS + c16 * 16) = pfx[i]; } }
#pragma unroll
        for (int i = 0; i < 4; ++i) { const int p = tz + 512 * i, r = p >> 3, c16 = p & 7; *(LAS u32x4*)(GA + r * LR_RS + c16 * 16) = pfg[i]; }
        __syncthreads();
        if (st + 1 < 8) LRU_PREFETCH(st + 1);
        float Aa[2][16], Uu[2][16];
#pragma unroll
        for (int mt = 0; mt < 2; ++mt) {
            float xc[2][8];
#pragma unroll
            for (int ks = 0; ks < 2; ++ks) {
                const int c0 = 32 * ks + 8 * fq;
                { const f32x4 b0 = *(const LAS f32x4*)(CB + c0), b1 = *(const LAS f32x4*)(CB + c0 + 4);
                  xc[ks][0] = b0[0]; xc[ks][1] = b0[1]; xc[ks][2] = b0[2]; xc[ks][3] = b0[3]; xc[ks][4] = b1[0]; xc[ks][5] = b1[1]; xc[ks][6] = b1[2]; xc[ks][7] = b1[3]; }
#pragma unroll
                for (int tap = 0; tap < 4; ++tap) {
                    const u32x4 xv = *(const LAS u32x4*)(XA + (w * 32 + 16 * mt + fr + tap) * LR_RS + c0 * 2);
                    const f32x4 w0 = *(const LAS f32x4*)(CW + tap * 64 + c0), w1 = *(const LAS f32x4*)(CW + tap * 64 + c0 + 4);
                    xc[ks][0] += w0[0] * lo16(xv.x); xc[ks][1] += w0[1] * hi16(xv.x); xc[ks][2] += w0[2] * lo16(xv.y); xc[ks][3] += w0[3] * hi16(xv.y);
                    xc[ks][4] += w1[0] * lo16(xv.z); xc[ks][5] += w1[1] * hi16(xv.z); xc[ks][6] += w1[2] * lo16(xv.w); xc[ks][7] += w1[3] * hi16(xv.w);
                }
            }
            bf16x8 xf[2];
#pragma unroll
            for (int ks = 0; ks < 2; ++ks) { u32x4 pw; pw.x = pk2(xc[ks][0], xc[ks][1]); pw.y = pk2(xc[ks][2], xc[ks][3]); pw.z = pk2(xc[ks][4], xc[ks][5]); pw.w = pk2(xc[ks][6], xc[ks][7]); xf[ks] = __builtin_bit_cast(bf16x8, pw); }
#pragma unroll
            for (int nt = 0; nt < 4; ++nt) {
                const int nact = 32 * (nt >> 1) + 8 * (fr >> 2) + 4 * (nt & 1) + (fr & 3);
                f32x4 ar = (f32x4){0.f, 0.f, 0.f, 0.f}, ax = (f32x4){0.f, 0.f, 0.f, 0.f};
#pragma unroll
                for (int ks = 0; ks < 2; ++ks) { const bf16x8 wa = *(const LAS bf16x8*)(WL + nact * 64 + 32 * ks + 8 * fq); const bf16x8 wx = *(const LAS bf16x8*)(WL + 4096 + nact * 64 + 32 * ks + 8 * fq);
                    ar = __builtin_amdgcn_mfma_f32_16x16x32_bf16(wa, xf[ks], ar, 0, 0, 0); ax = __builtin_amdgcn_mfma_f32_16x16x32_bf16(wx, xf[ks], ax, 0, 0, 0); }
                const int cb = 32 * (nt >> 1) + 8 * fq + 4 * (nt & 1);
                const f32x4 ba = *(const LAS f32x4*)(BA + cb), bx = *(const LAS f32x4*)(BX + cb), sp = *(const LAS f32x4*)(SP + cb);
#pragma unroll
                for (int r = 0; r < 4; ++r) {
                    const float rg = sigmoidf_(ar[r] + ba[r]), ig = sigmoidf_(ax[r] + bx[r]);
                    const float a = __builtin_amdgcn_exp2f(rg * sp[r]);
                    Aa[mt][4 * nt + r] = a; Uu[mt][4 * nt + r] = __builtin_amdgcn_sqrtf(fmaf(-a, a, 1.0f)) * ig * xc[nt >> 1][4 * (nt & 1) + r];
                }
            }
#define LRU_U8(D, o) asm volatile("s_nop 1\n\tv_fmac_f32_dpp %0, %0, %8 row_shr:" #D " row_mask:0xf bank_mask:0xf\n\tv_fmac_f32_dpp %1, %1, %9 row_shr:" #D " row_mask:0xf bank_mask:0xf\n\tv_fmac_f32_dpp %2, %2, %10 row_shr:" #D " row_mask:0xf bank_mask:0xf\n\tv_fmac_f32_dpp %3, %3, %11 row_shr:" #D " row_mask:0xf bank_mask:0xf\n\t" \
                "v_fmac_f32_dpp %4, %4, %12 row_shr:" #D " row_mask:0xf bank_mask:0xf\n\tv_fmac_f32_dpp %5, %5, %13 row_shr:" #D " row_mask:0xf bank_mask:0xf\n\tv_fmac_f32_dpp %6, %6, %14 row_shr:" #D " row_mask:0xf bank_mask:0xf\n\tv_fmac_f32_dpp %7, %7, %15 row_shr:" #D " row_mask:0xf bank_mask:0xf" \
                : "+v"(Uu[mt][o]), "+v"(Uu[mt][o + 1]), "+v"(Uu[mt][o + 2]), "+v"(Uu[mt][o + 3]), "+v"(Uu[mt][o + 4]), "+v"(Uu[mt][o + 5]), "+v"(Uu[mt][o + 6]), "+v"(Uu[mt][o + 7]) \
                : "v"(Aa[mt][o]), "v"(Aa[mt][o + 1]), "v"(Aa[mt][o + 2]), "v"(Aa[mt][o + 3]), "v"(Aa[mt][o + 4]), "v"(Aa[mt][o + 5]), "v"(Aa[mt][o + 6]), "v"(Aa[mt][o + 7]))
#define LRU_A8(D, o) asm volatile("s_nop 1\n\tv_mul_f32_dpp %0, %0, %0 row_shr:" #D " row_mask:0xf bank_mask:0xf\n\tv_mul_f32_dpp %1, %1, %1 row_shr:" #D " row_mask:0xf bank_mask:0xf\n\tv_mul_f32_dpp %2, %2, %2 row_shr:" #D " row_mask:0xf bank_mask:0xf\n\tv_mul_f32_dpp %3, %3, %3 row_shr:" #D " row_mask:0xf bank_mask:0xf\n\t" \
                "v_mul_f32_dpp %4, %4, %4 row_shr:" #D " row_mask:0xf bank_mask:0xf\n\tv_mul_f32_dpp %5, %5, %5 row_shr:" #D " row_mask:0xf bank_mask:0xf\n\tv_mul_f32_dpp %6, %6, %6 row_shr:" #D " row_mask:0xf bank_mask:0xf\n\tv_mul_f32_dpp %7, %7, %7 row_shr:" #D " row_mask:0xf bank_mask:0xf" \
                : "+v"(Aa[mt][o]), "+v"(Aa[mt][o + 1]), "+v"(Aa[mt][o + 2]), "+v"(Aa[mt][o + 3]), "+v"(Aa[mt][o + 4]), "+v"(Aa[mt][o + 5]), "+v"(Aa[mt][o + 6]), "+v"(Aa[mt][o + 7]))
#define LRU_STEP(D) do { LRU_U8(D, 0); LRU_U8(D, 8); LRU_A8(D, 0); LRU_A8(D, 8); } while (0)
            LRU_STEP(1); LRU_STEP(2); LRU_STEP(4); LRU_STEP(8);
#undef LRU_U8
#undef LRU_A8
#undef LRU_STEP
            asm volatile("s_nop 1" ::: "memory");
            asm volatile("" ::: "memory");
        }
#pragma unroll
        for (int e = 0; e < 16; ++e) { const float a0 = lane_read(Aa[0][e], lane | 15), u0 = lane_read(Uu[0][e], lane | 15);
            Uu[1][e] = Aa[1][e] * u0 + Uu[1][e]; Aa[1][e] = Aa[1][e] * a0; }
        if (fr == 15) {
#pragma unroll
            for (int e = 0; e < 16; ++e) { const int c = 32 * (e >> 3) + 8 * fq + (e & 7); *(LAS f32x2_t*)(AGG + (w * 64 + c) * 2) = (f32x2_t){Aa[1][e], Uu[1][e]}; } }
        __syncthreads();
        if (w == 0) { float hc = HC[lane];
#pragma unroll
            for (int ww = 0; ww < 8; ++ww) { HIN[ww * 64 + lane] = hc; hc = AGG[(ww * 64 + lane) * 2] * hc + AGG[(ww * 64 + lane) * 2 + 1]; }
            HC[lane] = hc; }
        __syncthreads();
        float hin[16];
#pragma unroll
        for (int e = 0; e < 16; ++e) hin[e] = HIN[w * 64 + 32 * (e >> 3) + 8 * fq + (e & 7)];
#pragma unroll
        for (int mt = 0; mt < 2; ++mt) {
            LAS unsigned char* grow = GA + (w * 32 + 16 * mt + fr) * LR_RS;
            u32x4 gv[2];
#pragma unroll
            for (int ks = 0; ks < 2; ++ks) gv[ks] = *(const LAS u32x4*)(grow + (32 * ks + 8 * fq) * 2);
#pragma unroll
            for (int ks = 0; ks < 2; ++ks) { float hv[8];
#pragma unroll
                for (int j2 = 0; j2 < 4; ++j2) { const int e0 = 8 * ks + 2 * j2;
                    const float h0 = Uu[mt][e0] + Aa[mt][e0] * hin[e0], h1 = Uu[mt][e0 + 1] + Aa[mt][e0 + 1] * hin[e0 + 1];
                    hv[2 * j2] = h0 * lo16(gv[ks][j2]) * (float)(1 << FP8_A_SHIFT); hv[2 * j2 + 1] = h1 * hi16(gv[ks][j2]) * (float)(1 << FP8_A_SHIFT); }
                u32x2 o8; o8.x = pk4_fp8(hv[0], hv[1], hv[2], hv[3]); o8.y = pk4_fp8(hv[4], hv[5], hv[6], hv[7]);
                *(LAS u32x2*)(grow + 32 * ks + 8 * fq) = o8; }
        }
        __syncthreads();
        asm volatile("" : "+v"(tz));
        { unsigned char* d8 = (unsigned char*)F.out + panl * H8_PANEL + 64 * g;
#pragma unroll
          for (int i = 0; i < 2; ++i) { const int p = tz + 512 * i, r = p >> 2, c = p & 3; *(u32x4*)(d8 + (size_t)r * 1024 + 16 * c) = *(const LAS u32x4*)(GA + r * LR_RS + 16 * c); } }
    }
}

#undef LRU_PREFETCH
__device__ __forceinline__ void phase_mixers(Frame& F, volatile LAS unsigned* MISC) {
    unsigned* head = (unsigned*)(F.ws + WS_CTL) + CW_MIXQ;
    for (;;) {
        __syncthreads();
        if (F.tid == 0) MISC[16] = __hip_atomic_fetch_add(head, 1u, __ATOMIC_RELAXED, __HIP_MEMORY_SCOPE_AGENT);
        __syncthreads();
        const int u = (int)MISC[16];
        if (u >= 128 + 512) break;
        if (u < 128) gla_unit(F, u >> 2, u & 3); else lru_unit(F, (u - 128) >> 4, (u - 128) & 15);
    }
}

__device__ __forceinline__ float wave_sum(float v) {
#pragma unroll
    for (int o = 1; o < 64; o <<= 1) v += __shfl_xor(v, o);
    return v;
}
__device__ __forceinline__ void ln_row(f32x4 (&v)[4]) {
    float s = 0.f;
#pragma unroll
    for (int j = 0; j < 4; ++j) s += (v[j][0] + v[j][1]) + (v[j][2] + v[j][3]);
    const float mean = wave_sum(s) * (1.f / 1024.f); float s2 = 0.f;
#pragma unroll
    for (int j = 0; j < 4; ++j) { v[j] = v[j] - mean; s2 += (v[j][0] * v[j][0] + v[j][1] * v[j][1]) + (v[j][2] * v[j][2] + v[j][3] * v[j][3]); }
    const float rstd = rsqrtf(wave_sum(s2) * (1.f / 1024.f) + LN_EPS);
#pragma unroll
    for (int j = 0; j < 4; ++j) v[j] = v[j] * rstd;
}
__device__ __forceinline__ void ln1_rows(Frame& F, int row_lo, int nrows) {
    PHASE_IDS(F);
    bf16* H = WSP(bf16, WS_H); unsigned char* H8P = (unsigned char*)F.out; constexpr float SC8 = (float)(1 << FP8_A_SHIFT);
    f32x4 gg[4], bb[4];
#pragma unroll
    for (int j = 0; j < 4; ++j) { gg[j] = *(const f32x4*)(F.in[15] + 8 * F.lane + 512 * (j >> 1) + 4 * (j & 1)); bb[j] = *(const f32x4*)(F.in[16] + 8 * F.lane + 512 * (j >> 1) + 4 * (j & 1)); }
    for (int r0 = row_lo + F.wave * 8; r0 < row_lo + nrows; r0 += 64) { u32x4 raw[8][2];
#pragma unroll
        for (int i = 0; i < 8; ++i)
#pragma unroll
            for (int j2 = 0; j2 < 2; ++j2) raw[i][j2] = *(const u32x4*)(H + (size_t)(r0 + i) * 1024 + 8 * F.lane + 512 * j2);
#pragma unroll
        for (int i = 0; i < 8; ++i) { f32x4 v[4]; unpack8(raw[i][0], v[0], v[1]); unpack8(raw[i][1], v[2], v[3]);
            ln_row(v);
#pragma unroll
            for (int j2 = 0; j2 < 2; ++j2) { const f32x4 o0 = v[2 * j2] * gg[2 * j2] + bb[2 * j2], o1 = v[2 * j2 + 1] * gg[2 * j2 + 1] + bb[2 * j2 + 1];
                *(u32x4*)(H + (size_t)(r0 + i) * 1024 + 8 * F.lane + 512 * j2) = pack8(o0, o1);
                u32x2 q; q.x = pk4_fp8(o0[0] * SC8, o0[1] * SC8, o0[2] * SC8, o0[3] * SC8); q.y = pk4_fp8(o1[0] * SC8, o1[1] * SC8, o1[2] * SC8, o1[3] * SC8);
                *(u32x2*)(H8P + (size_t)((r0 + i) >> 8) * H8_PANEL + ((r0 + i) & 255) * 1024 + 8 * F.lane + 512 * j2) = q; } } }
}
__device__ __forceinline__ void phase_combine(Frame& F) {
    PHASE_IDS(F);
    constexpr int NT = 2;
    const int gw = blockIdx.x * 8 + F.wave, NGW = gridDim.x * 8; const unsigned char* Y = WSP(unsigned char, WS_Y8); const int* ts = WSP(int, WS_TSLOT); const float* wt = WSP(float, WS_WT); const bf16* HR = WSP(bf16, WS_H);
    f32x4 gg[4], bb[4];
#pragma unroll
    for (int j = 0; j < 4; ++j) { gg[j] = *(const f32x4*)(F.in[25] + 16 * F.lane + 4 * j); bb[j] = *(const f32x4*)(F.in[26] + 16 * F.lane + 4 * j); }
    u32x4 s0n[NT], s1n[NT]; f32x4 w0n[NT], w1n[NT];
#pragma unroll
    for (int i = 0; i < NT; ++i) { const size_t t = (size_t)(gw * NT + i); s0n[i] = *(const u32x4*)(ts + t * 8); s1n[i] = *(const u32x4*)(ts + t * 8 + 4); w0n[i] = *(const f32x4*)(wt + t * 8); w1n[i] = *(const f32x4*)(wt + t * 8 + 4); }
    for (int t0 = gw * NT; t0 < T; t0 += NGW * NT) {
        u32x4 s0[NT], s1[NT]; f32x4 w0[NT], w1[NT];
#pragma unroll
        for (int i = 0; i < NT; ++i) { s0[i] = s0n[i]; s1[i] = s1n[i]; w0[i] = w0n[i]; w1[i] = w1n[i]; }
        if (t0 + NGW * NT < T) {
#pragma unroll
            for (int i = 0; i < NT; ++i) { const size_t t = (size_t)(t0 + NGW * NT + i); s0n[i] = *(const u32x4*)(ts + t * 8); s1n[i] = *(const u32x4*)(ts + t * 8 + 4); w0n[i] = *(const f32x4*)(wt + t * 8); w1n[i] = *(const f32x4*)(wt + t * 8 + 4); } }
        u32x4 y[NT][8];
#pragma unroll
        for (int i = 0; i < NT; ++i) {
#pragma unroll
            for (int k = 0; k < 8; ++k) { const unsigned sl = k < 4 ? s0[i][k & 3] : s1[i][k & 3]; y[i][k] = *(const u32x4*)(Y + (size_t)sl * 1024 + 16 * F.lane); } }
        f32x4 v[NT][4];
#pragma unroll
        for (int i = 0; i < NT; ++i) { const u32x4 r0 = *(const u32x4*)(HR + (size_t)(t0 + i) * 1024 + 16 * F.lane), r1 = *(const u32x4*)(HR + (size_t)(t0 + i) * 1024 + 16 * F.lane + 8);
            unpack8(r0, v[i][0], v[i][1]); unpack8(r1, v[i][2], v[i][3]); }
#pragma unroll
        for (int i = 0; i < NT; ++i) {
#pragma unroll
            for (int k = 0; k < 8; ++k) { const float w = (k < 4 ? w0[i][k & 3] : w1[i][k & 3]) * (1.0f / (float)(1 << FP8_Y_SHIFT));
#pragma unroll
                for (int j = 0; j < 4; ++j) { const f32x2_t lo = __builtin_amdgcn_cvt_pk_f32_fp8((int)y[i][k][j], false), hi = __builtin_amdgcn_cvt_pk_f32_fp8((int)y[i][k][j], true);
                    v[i][j][0] += w * lo.x; v[i][j][1] += w * lo.y; v[i][j][2] += w * hi.x; v[i][j][3] += w * hi.y; } }
            ln_row(v[i]);
#pragma unroll
            for (int j = 0; j < 4; ++j) *(f32x4*)(F.out + (size_t)(t0 + i) * 1024 + 16 * F.lane + 4 * j) = v[i][j] * gg[j] + bb[j]; }
    }
}

__device__ __forceinline__ void phase_h_to_fp8(Frame& F) {
    PHASE_IDS(F);
    constexpr float SC = (float)(1 << FP8_A_SHIFT);
    for (int pm = blockIdx.x; pm < T / 256; pm += gridDim.x) {
        const u32x4* H = WSP(u32x4, WS_H) + (size_t)pm * 256 * 128; u32x2* H8 = WSP(u32x2, WS_H8) + (size_t)pm * 256 * 128;
        for (int i = F.tid; i < 256 * 128; i += 4 * 512) { u32x4 v[4];
#pragma unroll
            for (int j = 0; j < 4; ++j) v[j] = H[i + j * 512];
#pragma unroll
            for (int j = 0; j < 4; ++j) { f32x4 a, b; unpack8(v[j], a, b); u32x2 o; o.x = pk4_fp8(a[0] * SC, a[1] * SC, a[2] * SC, a[3] * SC); o.y = pk4_fp8(b[0] * SC, b[1] * SC, b[2] * SC, b[3] * SC); H8[i + j * 512] = o; } }
    }
    asm volatile("s_waitcnt vmcnt(0)" ::: "memory"); __syncthreads();
}

constexpr int RT_HIST = 0, RT_GS = 1024, RT_RB = 5120, RT_LG = 6144, RT_STRIDE = 257;
static_assert(RT_LG + 128 * RT_STRIDE * 4 <= MISC_OFF, "routing LDS");
__device__ __forceinline__ void route_block(Frame& F, int tb) {
    LAS int* hist = (LAS int*)(F.lds + RT_HIST); LAS float* GS = (LAS float*)(F.lds + RT_GS); LAS float* LS = (LAS float*)(F.lds + RT_LG);
    const float* LG = WSP(float, WS_LG); const float* rb = F.in[18];
    int* IDX = WSP(int, WS_IDX); float* WT = WSP(float, WS_WT); int* RANK = WSP(int, WS_RANK); int* CNT = WSP(int, WS_CNT);
    __syncthreads();
    LAS float* RB = (LAS float*)(F.lds + RT_RB);
    if (F.tid < 256) { hist[F.tid] = 0; RB[F.tid] = rb[F.tid]; }
    const f32x4 rbv = *(const f32x4*)(rb + (F.tid & 63) * 4);
    for (int half = 0; half < 2; ++half) {
        __syncthreads();
        { const f32x4* src = (const f32x4*)(LG + ((size_t)tb * 256 + half * 128) * 256);
          f32x4 lv[16];
#pragma unroll
          for (int i = 0; i < 16; ++i) lv[i] = src[F.tid + 512 * i];
#pragma unroll
          for (int i = 0; i < 16; ++i) { const int q = F.tid + 512 * i; const f32x4 v = lv[i]; const int r = q >> 6, c = (q & 63) * 4; LAS float* d = LS + r * RT_STRIDE + c;
              d[0] = sigmoidf_(v[0]) + rbv[0]; d[1] = sigmoidf_(v[1]) + rbv[1]; d[2] = sigmoidf_(v[2]) + rbv[2]; d[3] = sigmoidf_(v[3]) + rbv[3]; } }
        __syncthreads();
        { const int tok = F.tid >> 2, part = F.tid & 3; LAS float* lg = LS + tok * RT_STRIDE;
#pragma unroll
          for (int gg = 0; gg < 2; ++gg) { const int g = 2 * part + gg; float m1 = -INFINITY, m2 = -INFINITY;
#pragma unroll 8
              for (int i = 0; i < 32; ++i) { const float v = lg[32 * g + ((i + 8 * part) & 31)]; if (v > m1) { m2 = m1; m1 = v; } else if (v > m2) m2 = v; }
              GS[tok * 8 + g] = m1 + m2; } }
        __syncthreads();
        if (F.tid < 128) {
            const int t = tb * 256 + half * 128 + F.tid; LAS float* lg = LS + F.tid * RT_STRIDE;
            float gs[8];
            { const f32x4 g0 = *(const LAS f32x4*)(GS + F.tid * 8), g1 = *(const LAS f32x4*)(GS + F.tid * 8 + 4); gs[0] = g0[0]; gs[1] = g0[1]; gs[2] = g0[2]; gs[3] = g0[3]; gs[4] = g1[0]; gs[5] = g1[1]; gs[6] = g1[2]; gs[7] = g1[3]; }
            unsigned gmask = 0u;
#pragma unroll
            for (int p = 0; p < 4; ++p) { float best = -INFINITY; int bi = 0;
#pragma unroll
                for (int g = 0; g < 8; ++g) { const bool ok = !((gmask >> g) & 1u) && gs[g] > best; best = ok ? gs[g] : best; bi = ok ? g : bi; }
                gmask |= 1u << bi; }
            float tv[8]; int ti[8];
#pragma unroll
            for (int k = 0; k < 8; ++k) { tv[k] = -INFINITY; ti[k] = 0; }
            for (int g = 0; g < 8; ++g) { if (!((gmask >> g) & 1u)) continue;
                for (int i = 0; i < 32; ++i) { const int e = 32 * g + i; float v = lg[e]; int id = e;
                    if (v > tv[7]) {
#pragma unroll
                        for (int k = 0; k < 8; ++k) { const bool sw = v > tv[k]; const float tvk = tv[k]; const int tik = ti[k]; tv[k] = sw ? v : tvk; ti[k] = sw ? id : tik; v = sw ? tvk : v; id = sw ? tik : id; } } } }
            float sc[8], ssum = 0.f;
#pragma unroll
            for (int k = 0; k < 8; ++k) { sc[k] = tv[k] - RB[ti[k]]; ssum += sc[k]; }
            const float inv = 2.5f / ssum;
#pragma unroll
            for (int k = 0; k < 8; ++k) { IDX[(size_t)t * 8 + k] = ti[k]; WT[(size_t)t * 8 + k] = sc[k] * inv; RANK[(size_t)t * 8 + k] = __hip_atomic_fetch_add(&hist[ti[k]], 1, __ATOMIC_RELAXED, __HIP_MEMORY_SCOPE_WORKGROUP); }
        }
    }
    __syncthreads();
    if (F.tid < 256) CNT[tb * 256 + F.tid] = hist[F.tid];
}
__device__ __forceinline__ void phase_route_own(Frame& F) {
    PHASE_IDS(F);
    asm volatile("s_waitcnt vmcnt(0)" ::: "memory"); __syncthreads();
    for (int pm = blockIdx.x; pm < T / 256; pm += gridDim.x) route_block(F, pm);
}
__device__ __forceinline__ void phase_slots(Frame& F) {
    PHASE_IDS(F);
    LAS int* base = (LAS int*)F.lds; LAS int* pad = base + 256; LAS int* tot = base + 512; LAS int* pst = base + 768; LAS int* part = base + 1280;
    const int* IDX = WSP(int, WS_IDX); const int* RANK = WSP(int, WS_RANK); const int* CNT = WSP(int, WS_CNT);
    int* TSLOT = WSP(int, WS_TSLOT); int* STOK = WSP(int, WS_STOK); int* TILE = WSP(int, WS_TILE);
    for (int tb = blockIdx.x; tb < T / 256; tb += gridDim.x) {
        __syncthreads();
        { const int e = F.tid & 255, hh = F.tid >> 8; int run = 0, mine = 0; const int* c = CNT + (size_t)hh * 128 * 256 + e;
#pragma unroll 16
          for (int j = 0; j < 128; ++j) { const int v = c[j * 256]; run += v; mine += (hh * 128 + j < tb) ? v : 0; }
          if (hh) { part[2 * e] = run; part[2 * e + 1] = mine; }
          __syncthreads();
          if (!hh) { run += part[2 * e]; mine += part[2 * e + 1]; base[e] = mine; tot[e] = run; pad[e] = (run + 255) & ~255; } }
        __syncthreads();
        if (F.tid < 64) { const int p0 = pad[4 * F.tid], p1 = pad[4 * F.tid + 1], p2 = pad[4 * F.tid + 2], p3 = pad[4 * F.tid + 3]; const int sl = p0 + p1 + p2 + p3;
            const int incl = (int)wave_incl_scan((float)sl), ex = incl - sl;
            pst[4 * F.tid] = ex; pst[4 * F.tid + 1] = ex + p0; pst[4 * F.tid + 2] = ex + p0 + p1; pst[4 * F.tid + 3] = ex + p0 + p1 + p2; if (F.tid == 63) pst[256] = incl; }
        __syncthreads();
        if (F.tid < 256) {
            const int t = tb * 256 + F.tid;
            const u32x4 i0 = *(const u32x4*)(IDX + (size_t)t * 8), i1 = *(const u32x4*)(IDX + (size_t)t * 8 + 4), r0 = *(const u32x4*)(RANK + (size_t)t * 8), r1 = *(const u32x4*)(RANK + (size_t)t * 8 + 4);
            u32x4 s0, s1;
#pragma unroll
            for (int k = 0; k < 4; ++k) { s0[k] = (unsigned)(pst[i0[k]] + base[i0[k]]) + r0[k]; s1[k] = (unsigned)(pst[i1[k]] + base[i1[k]]) + r1[k]; }
            *(u32x4*)(TSLOT + (size_t)t * 8) = s0; *(u32x4*)(TSLOT + (size_t)t * 8 + 4) = s1;
            const int rowidx = (t >> 8) * 512 + (t & 255);
#pragma unroll
            for (int k = 0; k < 4; ++k) { STOK[s0[k]] = rowidx; STOK[s1[k]] = rowidx; }
            if (F.tid == 0) { const int e = tb; for (int sp = pst[e] + tot[e]; sp < pst[e] + pad[e]; ++sp) STOK[sp] = 0;
                for (int tl = pst[e] >> 8; tl < (pst[e] + pad[e]) >> 8; ++tl) TILE[tl] = e;
                if (e == 0) TILE[4096] = pst[256] >> 8; }
        }
    }
}

#if GEMM_FAST
#define GEMM_PHASE(lds_, pv_, ep_) gemm_phase_pg8<decltype(pv_), decltype(ep_), PG_ALIGN, PG_SP2>(lds_, pv_, ep_, F.tid)
#define GEMM_PHASE_NA(lds_, pv_, ep_) gemm_phase_pg8<decltype(pv_), decltype(ep_), false, PG_SP2>(lds_, pv_, ep_, F.tid)
#else
#define GEMM_PHASE(lds_, pv_, ep_) gemm_phase_simple(lds_, pv_, ep_, F.tid)
#define GEMM_PHASE_NA(lds_, pv_, ep_) gemm_phase_simple(lds_, pv_, ep_, F.tid)
#endif
enum { PH_PRO = 0, PH_INPROJ, PH_MIX, PH_MERGE, PH_MID, PH_SLOTS, PH_GU, PH_DOWN, PH_COMB, PH_COUNT };

template <int LO, int HI>
__global__ void __launch_bounds__(512, 2) mega(const Params prm) {
    extern __shared__ __attribute__((aligned(16))) unsigned char lds_raw[];
    Frame F;
    F.lds = (LAS unsigned char*)lds_raw; F.tid = threadIdx.x; F.lane = F.tid & 63; F.wave = __builtin_amdgcn_readfirstlane(F.tid >> 6);
    F.in = prm.in; F.out = prm.out; F.ws = prm.ws;
    volatile LAS unsigned* MISC = (volatile LAS unsigned*)(F.lds + MISC_OFF);
    constexpr bool MULTI = (HI - LO > 1);
    XcdBarrier bar; bar.bar = (unsigned*)(F.ws + WS_CTL) + CW_BAR; bar.x = 0; bar.st = MISC + 8;
    if (F.tid < 32) MISC[F.tid] = 0u;
    __syncthreads();
    if constexpr (MULTI) bar = xcd_barrier_post((unsigned*)(F.ws + WS_CTL) + CW_BAR, MISC + 8, F.tid);
#define IN(k) (LO <= (k) && (k) < HI)
#define SEAM(k) do { if constexpr (IN(k) && IN((k) + 1)) xcd_barrier(bar, F.tid); } while (0)

    if constexpr (IN(PH_PRO)) { for (int rep_ = 0; rep_ < (PROBE_PHASE == PH_PRO ? 2 : 1); ++rep_) { if (rep_) xcd_barrier(bar, F.tid); phase_prologue(F); } } SEAM(PH_PRO);
#if INPROJ_FP8
    if constexpr (IN(PH_INPROJ)) { ProvDense8 pv{(const unsigned char*)F.out + (size_t)T * 2048, WSP(unsigned char, WS_WIN), 1024, 256, 29}; EpiInProj ep{WSP(bf16, WS_P), WSP(float, WS_GL), F.lds}; GEMM_PHASE(F.lds, pv, ep); } SEAM(PH_INPROJ);
#else
    if constexpr (IN(PH_INPROJ)) { for (int rep_ = 0; rep_ < (PROBE_PHASE == PH_INPROJ ? 2 : 1); ++rep_) { if (rep_) xcd_barrier(bar, F.tid); ProvDense pv{(const bf16*)F.out, WSP(bf16, WS_WIN), 1024, 1024, 256, 29}; EpiInProj ep{WSP(bf16, WS_P), WSP(float, WS_GL), F.lds}; GEMM_PHASE(F.lds, pv, ep); } } SEAM(PH_INPROJ);
#endif
    if constexpr (IN(PH_MIX)) { phase_mixers(F, MISC); } SEAM(PH_MIX);
    if constexpr (IN(PH_MERGE)) {
        { ProvPanel8 pv{(const unsigned char*)F.out, WSP(unsigned char, WS_WA), 1024, 256, 4, H8_PANEL}; EpiGateMul ep{WSP(bf16, WS_P), C_GTA, nullptr, nullptr, WSP(unsigned char, WS_H), H8_PANEL, F.lds}; GEMM_PHASE(F.lds, pv, ep); }
        asm volatile("s_waitcnt vmcnt(0)" ::: "memory"); __syncthreads();
        { ProvPanel8 pv{(const unsigned char*)F.out + 262144, WSP(unsigned char, WS_WB), 1024, 256, 4, H8_PANEL}; EpiGateMul ep{WSP(bf16, WS_P), C_GTB, WSP(unsigned char, WS_H), nullptr, (unsigned char*)F.out + (size_t)T * 2048, 256 * 1024, F.lds}; GEMM_PHASE(F.lds, pv, ep); }
        asm volatile("s_waitcnt vmcnt(0)" ::: "memory"); __syncthreads();
        { ProvPanel8 pv{(const unsigned char*)F.out + (size_t)T * 2048, WSP(unsigned char, WS_WO), 1024, 256, 4, 256 * 1024}; EpiHpre ep{F.in[0], WSP(bf16, WS_H), F.lds}; GEMM_PHASE(F.lds, pv, ep); }
        asm volatile("s_waitcnt vmcnt(0)" ::: "memory"); __syncthreads();
        for (int pm = blockIdx.x; pm < T / 256; pm += gridDim.x) ln1_rows(F, pm * 256, 256);
    } SEAM(PH_MERGE);
    if constexpr (IN(PH_MID)) for (int rep_ = 0; rep_ < (PROBE_PHASE == PH_MID ? 2 : 1); ++rep_) {
        if (rep_) xcd_barrier(bar, F.tid);
        const bool conv_first = (blockIdx.x & 1) != 0;
        if (conv_first) phase_expert_convert(F);
        { ProvPanel pv{WSP(bf16, WS_H), WSP(bf16, WS_WR), 1024, 1024, 256, 1}; EpiF32 ep{WSP(float, WS_LG), 256, F.lds}; GEMM_PHASE(F.lds, pv, ep); phase_route_own(F); }
        { ProvPanel8 pv{(const unsigned char*)F.out, WSP(unsigned char, WS_WSGU), 1024, 256, 2, H8_PANEL}; EpiSwiglu8 ep{WSP(unsigned char, WS_ACTSH), F.lds}; GEMM_PHASE(F.lds, pv, ep); }
        asm volatile("s_waitcnt vmcnt(0)" ::: "memory"); __syncthreads();
        { ProvPanel8 pv{WSP(unsigned char, WS_ACTSH), WSP(unsigned char, WS_WSD), 256, 256, 4, 256 * 256}; EpiShDown ep{WSP(bf16, WS_H), F.lds}; GEMM_PHASE(F.lds, pv, ep); }
        if (!conv_first) phase_expert_convert(F);
    } SEAM(PH_MID);
    if constexpr (IN(PH_SLOTS)) { for (int rep_ = 0; rep_ < (PROBE_PHASE == PH_SLOTS ? 2 : 1); ++rep_) { if (rep_) xcd_barrier(bar, F.tid); phase_slots(F); } } SEAM(PH_SLOTS);
    if constexpr (IN(PH_GU)) { for (int rep_ = 0; rep_ < (PROBE_PHASE == PH_GU ? 2 : 1); ++rep_) { if (rep_) xcd_barrier(bar, F.tid); const int ntl = __builtin_amdgcn_readfirstlane(WSP(int, WS_TILE)[4096]); ProvGateUp pv{(const unsigned char*)F.out, WSP(unsigned char, WS_WGU8), WSP(int, WS_STOK), WSP(int, WS_TILE), ntl, (LAS int*)(F.lds + PG_TAB_OFF)}; EpiSwiglu8 ep{WSP(unsigned char, WS_ACT8), F.lds}; GEMM_PHASE(F.lds, pv, ep); } } SEAM(PH_GU);
    if constexpr (IN(PH_DOWN)) { const int ntl = __builtin_amdgcn_readfirstlane(WSP(int, WS_TILE)[4096]);
        { ProvDown pv{WSP(unsigned char, WS_ACT8), WSP(unsigned char, WS_WD8), WSP(int, WS_TILE), ntl, 0, (LAS int*)(F.lds + PG_TAB_OFF)}; EpiFp8Tile ep{WSP(unsigned char, WS_Y8), F.lds}; GEMM_PHASE(F.lds, pv, ep); }
        { ProvDown pv{WSP(unsigned char, WS_ACT8), WSP(unsigned char, WS_WD8), WSP(int, WS_TILE), ntl, 1, (LAS int*)(F.lds + PG_TAB_OFF)}; EpiFp8Tile ep{WSP(unsigned char, WS_Y8), F.lds}; GEMM_PHASE(F.lds, pv, ep); } } SEAM(PH_DOWN);
    if constexpr (IN(PH_COMB)) { phase_combine(F); }
#undef IN
#undef SEAM
}
}

extern "C" void kernel_launch(void* const* d_in, const int* in_sizes, int n_in, void* d_out, int out_size, void* d_ws, size_t ws_size, hipStream_t stream) {
    static int grid = 0;
    if (grid == 0) {
        if (n_in != 27 || in_sizes[0] != T * D || out_size != T * D || ws_size < WS_END) { fprintf(stderr, "kernel_launch: unexpected problem (n_in %d, in0 %d, out %d, ws %zu < %zu); nothing launched\n", n_in, n_in > 0 ? in_sizes[0] : -1, out_size, ws_size, (size_t)WS_END); grid = -1; return; }
        int dev = 0, cus = 0;
        if (hipGetDevice(&dev) != hipSuccess || hipDeviceGetAttribute(&cus, hipDeviceAttributeMultiprocessorCount, dev) != hipSuccess) { grid = -1; return; }
        grid = cus;
    }
    if (grid < 0) return;
    (void)hipMemsetAsync((char*)d_ws + WS_CTL, 0, CTL_BYTES, stream);
    Params p{};
    for (int i = 0; i < 27; ++i) p.in[i] = (const float*)d_in[i];
    p.out = (float*)d_out; p.ws = (unsigned char*)d_ws; p.q_lo = 0; p.q_hi = 2;
#define LAUNCH(LO_, HI_) do { static bool attr_ = false; if (!attr_) { (void)hipFuncSetAttribute((const void*)mega<LO_, HI_>, hipFuncAttributeMaxDynamicSharedMemorySize, LDS_BYTES); attr_ = true; } \
        hipLaunchKernelGGL((mega<LO_, HI_>), dim3(grid), dim3(512), LDS_BYTES, stream, p); } while (0)
#if MK_N_LAUNCHES == 1
    LAUNCH(0, PH_COUNT);
#else
    LAUNCH(0, 1); LAUNCH(1, 2); LAUNCH(2, 3); LAUNCH(3, 4); LAUNCH(4, 5); LAUNCH(5, 6); LAUNCH(6, 7);
    LAUNCH(7, 8); LAUNCH(8, 9);
#endif
}
```
